# Optimizing an MI355X kernel written in HIP

```python
import jax, jax.numpy as jnp
from jax import lax
import numpy as np

D_MODEL = 2048
BATCH = 4
SEQ = 2048
DEPTH = 2

ATTN_HEADS = 8
HEAD_DIM = 128
ATTN_WIDTH = ATTN_HEADS * HEAD_DIM
MOBA_BLOCK = 256
MOBA_TOPK = 3
Q_CHUNK = 16
SGU_GROUPS = 8
SGU_GROUP_DIM = 128
SGU_WIDTH = SGU_GROUPS * SGU_GROUP_DIM
SGU_CHUNK = 128
D_FF = 5632
N_EXPERTS = 8
TOP_K = 2
D_FF_EXPERT = 5632
N_DENSE = (DEPTH + 1) // 2
N_MOE = DEPTH // 2
NORM_EPS = 1e-6
IN_SPLITS = (ATTN_WIDTH, ATTN_WIDTH, ATTN_WIDTH, SGU_WIDTH, SGU_WIDTH, D_MODEL, D_MODEL)
IN_WIDTH = sum(IN_SPLITS)

kernel_name = "hybrid_moba_sgu_moe_block"


def rmsnorm(x, g):
    xf = x.astype(jnp.float32)
    y = xf * lax.rsqrt(jnp.mean(xf * xf, axis=-1, keepdims=True) + NORM_EPS) * g.astype(jnp.float32)
    return y.astype(x.dtype)


def layernorm(x, g):
    xf = x.astype(jnp.float32)
    mu = jnp.mean(xf, axis=-1, keepdims=True)
    xc = xf - mu
    y = xc * lax.rsqrt(jnp.mean(xc * xc, axis=-1, keepdims=True) + NORM_EPS) * g.astype(jnp.float32)
    return y.astype(x.dtype)


def moba_attention(q, k, v):
    B, S, H, Dh = q.shape
    nb = -(-S // MOBA_BLOCK)
    sp = nb * MOBA_BLOCK
    pad = ((0, 0), (0, sp - S), (0, 0), (0, 0))
    q, k, v = [jnp.pad(t, pad).transpose(0, 2, 1, 3) for t in (q, k, v)]
    scale = Dh ** -0.5
    kb = k.reshape(B, H, nb, MOBA_BLOCK, Dh)
    vb = v.reshape(B, H, nb, MOBA_BLOCK, Dh)
    k_mean = jnp.mean(kb.astype(jnp.float32), axis=3)
    gate = jnp.einsum('bhsd,bhnd->bhsn', q.astype(jnp.float32), k_mean)
    q_blk = jnp.arange(sp) // MOBA_BLOCK
    past = jnp.arange(nb)[None, :] < q_blk[:, None]
    gate = jnp.where(past, gate, -jnp.inf)
    k_sel = min(MOBA_TOPK, nb)
    _, sel = lax.top_k(gate, k_sel)
    sel_valid = sel < q_blk[:, None]
    b_ix = jnp.arange(B)[:, None, None, None]
    h_ix = jnp.arange(H)[None, :, None, None]

    def attend_chunk(c):
        start = c * Q_CHUNK
        qc = lax.dynamic_slice_in_dim(q, start, Q_CHUNK, axis=2)
        sc = lax.dynamic_slice_in_dim(sel, start, Q_CHUNK, axis=2)
        vc = lax.dynamic_slice_in_dim(sel_valid, start, Q_CHUNK, axis=2)
        kg = kb[b_ix, h_ix, sc]
        vg = vb[b_ix, h_ix, sc]
        s_sel = jnp.einsum('bhqd,bhqkjd->bhqkj', qc, kg).astype(jnp.float32) * scale
        s_sel = jnp.where(vc[..., None], s_sel, -jnp.inf).reshape(B, H, Q_CHUNK, k_sel * MOBA_BLOCK)
        own = start // MOBA_BLOCK
        ko = lax.dynamic_slice_in_dim(k, own * MOBA_BLOCK, MOBA_BLOCK, axis=2)
        vo = lax.dynamic_slice_in_dim(v, own * MOBA_BLOCK, MOBA_BLOCK, axis=2)
        s_own = jnp.einsum('bhqd,bhjd->bhqj', qc, ko).astype(jnp.float32) * scale
        q_pos = start + jnp.arange(Q_CHUNK)
        k_pos = own * MOBA_BLOCK + jnp.arange(MOBA_BLOCK)
        s_own = jnp.where(k_pos[None, :] <= q_pos[:, None], s_own, -jnp.inf)
        p = jax.nn.softmax(jnp.concatenate([s_sel, s_own], axis=-1), axis=-1)
        p_sel = p[..., :k_sel * MOBA_BLOCK].reshape(B, H, Q_CHUNK, k_sel, MOBA_BLOCK).astype(v.dtype)
        p_own = p[..., k_sel * MOBA_BLOCK:].astype(v.dtype)
        return (jnp.einsum('bhqkj,bhqkjd->bhqd', p_sel, vg)
                + jnp.einsum('bhqj,bhjd->bhqd', p_own, vo))

    outs = lax.map(attend_chunk, jnp.arange(sp // Q_CHUNK))
    out = outs.transpose(1, 0, 3, 2, 4).reshape(B, sp, H, Dh)
    return out[:, :S]


def spatial_gating(u, vg, g_sgu, w_s, b_s):
    B, S, _ = u.shape
    u = jax.nn.gelu(u)
    vn = layernorm(jax.nn.gelu(vg), g_sgu)
    nc = S // SGU_CHUNK
    vr = vn.reshape(B, nc, SGU_CHUNK, SGU_GROUPS, SGU_GROUP_DIM)
    mask = jnp.tril(jnp.ones((SGU_CHUNK, SGU_CHUNK), dtype=bool))
    w = jnp.where(mask, w_s, jnp.zeros_like(w_s))
    mixed = jnp.einsum('gts,bcsgd->bctgd', w, vr) + b_s.T[None, None, :, :, None]
    return u * mixed.reshape(B, S, SGU_WIDTH)


def token_mixer(h, w_in, g_sgu, w_s, b_s, w_pa, w_pb, w_o):
    B, S, _ = h.shape
    z = h @ w_in
    offs = np.cumsum(IN_SPLITS)[:-1].tolist()
    q, k, v, u, vg, ga, gb = jnp.split(z, offs, axis=-1)
    shp = (B, S, ATTN_HEADS, HEAD_DIM)
    attn = moba_attention(q.reshape(shp), k.reshape(shp), v.reshape(shp)).reshape(B, S, ATTN_WIDTH)
    sgu = spatial_gating(u, vg, g_sgu, w_s, b_s)
    merged = jax.nn.sigmoid(ga) * (attn @ w_pa) + jax.nn.sigmoid(gb) * (sgu @ w_pb)
    return merged @ w_o


def swiglu(t, wg, wu, wd):
    return (jax.nn.silu(t @ wg) * (t @ wu)) @ wd


def moe_swiglu(h, w_router, b_router, wg, wu, wd):
    B, S, D = h.shape
    t = h.reshape(B * S, D)
    logits = (t @ w_router).astype(jnp.float32) + b_router.astype(jnp.float32)
    top_val, top_idx = lax.top_k(logits, TOP_K)
    top_w = jax.nn.softmax(top_val, axis=-1)
    combine = jnp.sum(jax.nn.one_hot(top_idx, N_EXPERTS, dtype=jnp.float32) * top_w[..., None], axis=1)
    combine = combine.astype(t.dtype)
    out = jnp.zeros_like(t)
    for e in range(N_EXPERTS):
        out = out + combine[:, e:e + 1] * swiglu(t, wg[e], wu[e], wd[e])
    return out.reshape(B, S, D)


def setup_inputs(seed: int = 0) -> dict:
    key = jax.random.key(seed)
    ks = jax.random.split(key, 24)
    f32 = jnp.float32
    nrm = lambda k, shape, s: jax.random.normal(k, shape, f32) * s
    return {
        "x": nrm(ks[0], (BATCH, SEQ, D_MODEL), 1.0),
        "mix_norm_g": 1.0 + nrm(ks[1], (DEPTH, D_MODEL), 0.02),
        "w_in": nrm(ks[2], (DEPTH, D_MODEL, IN_WIDTH), D_MODEL ** -0.5),
        "sgu_norm_g": 1.0 + nrm(ks[3], (DEPTH, SGU_WIDTH), 0.02),
        "w_s": nrm(ks[4], (DEPTH, SGU_GROUPS, SGU_CHUNK, SGU_CHUNK), SGU_CHUNK ** -0.5),
        "b_s": 1.0 + nrm(ks[5], (DEPTH, SGU_GROUPS, SGU_CHUNK), 0.01),
        "w_pa": nrm(ks[6], (DEPTH, ATTN_WIDTH, D_MODEL), ATTN_WIDTH ** -0.5),
        "w_pb": nrm(ks[7], (DEPTH, SGU_WIDTH, D_MODEL), SGU_WIDTH ** -0.5),
        "w_o": nrm(ks[8], (DEPTH, D_MODEL, D_MODEL), D_MODEL ** -0.5),
        "ffn_norm_g": 1.0 + nrm(ks[9], (DEPTH, D_MODEL), 0.02),
        "dense_w_gate": nrm(ks[10], (N_DENSE, D_MODEL, D_FF), D_MODEL ** -0.5),
        "dense_w_up": nrm(ks[11], (N_DENSE, D_MODEL, D_FF), D_MODEL ** -0.5),
        "dense_w_down": nrm(ks[12], (N_DENSE, D_FF, D_MODEL), D_FF ** -0.5),
        "router_w": nrm(ks[13], (N_MOE, D_MODEL, N_EXPERTS), D_MODEL ** -0.5),
        "router_b": nrm(ks[14], (N_MOE, N_EXPERTS), 0.01),
        "expert_w_gate": nrm(ks[15], (N_MOE, N_EXPERTS, D_MODEL, D_FF_EXPERT), D_MODEL ** -0.5),
        "expert_w_up": nrm(ks[16], (N_MOE, N_EXPERTS, D_MODEL, D_FF_EXPERT), D_MODEL ** -0.5),
        "expert_w_down": nrm(ks[17], (N_MOE, N_EXPERTS, D_FF_EXPERT, D_MODEL), D_FF_EXPERT ** -0.5),
        "final_norm_g": 1.0 + nrm(ks[18], (D_MODEL,), 0.02),
    }


def reference(x, mix_norm_g, w_in, sgu_norm_g, w_s, b_s, w_pa, w_pb, w_o, ffn_norm_g,
              dense_w_gate, dense_w_up, dense_w_down, router_w, router_b,
              expert_w_gate, expert_w_up, expert_w_down, final_norm_g):
    for i in range(DEPTH):
        h = rmsnorm(x, mix_norm_g[i])
        x = x + token_mixer(h, w_in[i], sgu_norm_g[i], w_s[i], b_s[i], w_pa[i], w_pb[i], w_o[i])
        h = rmsnorm(x, ffn_norm_g[i])
        j = i // 2
        if i % 2 == 0:
            x = x + swiglu(h, dense_w_gate[j], dense_w_up[j], dense_w_down[j])
        else:
            x = x + moe_swiglu(h, router_w[j], router_b[j], expert_w_gate[j], expert_w_up[j], expert_w_down[j])
    return rmsnorm(x, final_norm_g)
```

```cpp
#include <hip/hip_runtime.h>
#include <cstdio>
#include <cstdint>

#ifndef DBL_P0
#define DBL_P0 1
#endif
#ifndef ATT_KV2
#define ATT_KV2 1
#endif
#ifndef EXMASK
#define EXMASK 0x0u
#endif
#ifndef MK_ONE_LAUNCH
#define MK_ONE_LAUNCH 1
#endif

#define LAS __attribute__((address_space(3)))
#define GAS __attribute__((address_space(1)))
typedef unsigned short bf16_t;
typedef short bf16x8 __attribute__((ext_vector_type(8)));
typedef short s16x4 __attribute__((ext_vector_type(4)));
typedef float f32x2 __attribute__((ext_vector_type(2)));
typedef float f32x4 __attribute__((ext_vector_type(4)));
typedef float f32x16 __attribute__((ext_vector_type(16)));
typedef unsigned u32x2 __attribute__((ext_vector_type(2)));
typedef unsigned u32x4 __attribute__((ext_vector_type(4)));
typedef int i32x4 __attribute__((ext_vector_type(4)));

constexpr int NTOK = 8192, DM = 2048, SEQ = 2048, NBATCH = 4, NHEAD = 8, HDIM = 128, AW = 1024, SW = 1024, INW = 9216, FF = 5632, NEXP = 8;
constexpr int NSLOT = 18432;
constexpr float EPS = 1e-6f;

constexpr size_t MiB = 1u << 20;
constexpr size_t WS_CTL = 0;
constexpr size_t WS_WIN = 1 * MiB;
constexpr size_t WS_WPA = WS_WIN + 72 * MiB;
constexpr size_t WS_WPB = WS_WPA + 8 * MiB;
constexpr size_t WS_WO = WS_WPB + 8 * MiB;
constexpr size_t WS_WGU = WS_WO + 16 * MiB;
constexpr size_t WS_WD = WS_WGU + 44 * MiB;
constexpr size_t WS_WEGU = WS_WD + 22 * MiB;
constexpr size_t WS_WED = WS_WEGU + 352 * MiB;
constexpr size_t WS_WS = WS_WED + 176 * MiB;
constexpr size_t WS_X = WS_WS + 1 * MiB;
constexpr size_t WS_H = WS_X + 64 * MiB;
constexpr size_t WS_RT = WS_H + 32 * MiB;
constexpr size_t WS_R = WS_RT + 1 * MiB;
constexpr size_t WS_QKVUV = WS_R;
constexpr size_t WS_GAB = WS_R + 80 * MiB;
constexpr size_t WS_ATT = WS_R + 144 * MiB;
constexpr size_t WS_SGU = WS_R + 160 * MiB;
constexpr size_t WS_P1 = WS_R + 176 * MiB;
constexpr size_t WS_MRG = WS_R + 240 * MiB;
constexpr size_t WS_ACT = WS_R;
constexpr size_t WS_XG = WS_R + 198 * MiB;
constexpr size_t WS_Y = WS_R + 270 * MiB;
constexpr size_t WS_YP = WS_R + 414 * MiB;
constexpr size_t WS_SB = WS_YP + 48 * MiB;
constexpr int SB_WIN = 9 * 11264;
constexpr int SB_WD = 896 * 256 + 8 * 2048;
constexpr int SB_WED = 896 * 256;
constexpr size_t WS_END = WS_SB + 1 * MiB;
constexpr size_t RT_TE = 0, RT_TP = 65536, RT_TW = 131072, RT_TS = 196608, RT_CW = 262144, RT_KSUM = 524288;

constexpr int CW_CNT = 64;
constexpr int CW_Q8Q = 3072;
constexpr int CW_ROUTED = 2048;
constexpr int CW_BAR = 4096;
constexpr int CW_QH = 8192;
constexpr int CW_DONE = 16384;

#ifndef P8
#define P8 2176
#endif
constexpr int P8B = P8;
constexpr int RING_BYTES = 131072;
constexpr int MISC_OFF = RING_BYTES + 320;
constexpr int SCL_OFF = RING_BYTES + 4096;
constexpr int LDS_BYTES = 147456;

__device__ __forceinline__ unsigned cvt_pk_bf16(float lo, float hi) { unsigned r; asm volatile("v_cvt_pk_bf16_f32 %0, %1, %2" : "=v"(r) : "v"(lo), "v"(hi)); return r; }
__device__ __forceinline__ float bf2f(unsigned short b) { return __uint_as_float(((unsigned)b) << 16); }
__device__ __forceinline__ float bflo(unsigned w) { return __uint_as_float(w << 16); }
__device__ __forceinline__ float bfhi(unsigned w) { return __uint_as_float(w & 0xffff0000u); }
__device__ __forceinline__ float sigmoid_f(float x) { return __builtin_amdgcn_rcpf(1.0f + __builtin_amdgcn_exp2f(-1.4426950408889634f * x)); }
__device__ __forceinline__ float silu_f(float x) { return x * sigmoid_f(x); }
__device__ __forceinline__ float gelu_f(float x) { const float y = 0.7978845608028654f * (x + 0.044715f * x * x * x); return x * __builtin_amdgcn_rcpf(1.0f + __builtin_amdgcn_exp2f(-2.8853900817779268f * y)); }
__device__ __forceinline__ float wave_sum(float v) {
#pragma unroll
    for (int o = 1; o < 64; o <<= 1) v += __shfl_xor(v, o);
    return v;
}
__device__ __forceinline__ float wave_max(float v) {
#pragma unroll
    for (int o = 1; o < 64; o <<= 1) v = fmaxf(v, __shfl_xor(v, o));
    return v;
}
__device__ __forceinline__ unsigned pack_i8x4(f32x4 v, float inv) {
    const unsigned a = __float_as_uint(__builtin_fmaf(v.x, inv, 12582912.0f)), b = __float_as_uint(__builtin_fmaf(v.y, inv, 12582912.0f));
    const unsigned c = __float_as_uint(__builtin_fmaf(v.z, inv, 12582912.0f)), d = __float_as_uint(__builtin_fmaf(v.w, inv, 12582912.0f));
    return __builtin_amdgcn_perm(b, a, 0x0c0c0400u) | (__builtin_amdgcn_perm(d, c, 0x0c0c0400u) << 16);
}
__device__ __forceinline__ int lane_id() { int r; asm volatile("v_mbcnt_lo_u32_b32 %0, -1, 0\n\tv_mbcnt_hi_u32_b32 %0, -1, %0" : "=v"(r)); return r; }
#define LDS_WAIT() asm volatile("s_waitcnt lgkmcnt(0)" ::: "memory")
#define VM_WAIT() asm volatile("s_waitcnt vmcnt(0)" ::: "memory")

namespace pg8 {
constexpr int BM = 256, BK = 64, HALF = 128, HTB = HALF * BK * 2, STAGE_BYTES = 8 * HTB, NXCD = 8, WGM = 8;
__host__ __device__ __forceinline__ int lds_byte(int r, int c) { const int st = (r >> 4) * 2 + (c >> 5), rr = r & 15, cc = c & 31, ob = rr * 64 + cc * 2; return st * 1024 + (ob ^ (((ob >> 9) & 1) << 5)); }
__host__ __device__ __forceinline__ void stage_rc(int b, int& R, int& C) { const int st = b / 1024, sb = b % 1024, swz = sb ^ (((sb >> 9) & 1) << 5); R = (st >> 1) * 16 + swz / 64; C = (st & 1) * 32 + (swz % 64) / 2; }
__host__ __device__ __forceinline__ int perm32(int rho) { const int n = rho >> 4, i = rho & 15; return 8 * (i >> 2) + 4 * n + (i & 3); }

struct Unit { int pm, pn, kind; };
struct Gemm { const bf16_t* A; const bf16_t* Bt; int M, N, K; int lda, ldb; };

struct StaticOrder {
    static constexpr bool VAR_K = false;
    int nM, nN, nwg, G, c;
    __device__ void init(int M, int N, int G_, int c_) { nM = M / BM; nN = N / BM; nwg = nM * nN; G = G_; c = c_; }
    __device__ bool next(int i, Unit& u) const {
        const long L = (long)i * G + c; if (L >= nwg) return false;
        int wgid = (int)L; { const int q = nwg / NXCD, r = nwg % NXCD, xcd = wgid % NXCD, off = wgid / NXCD; wgid = (xcd < r ? xcd * (q + 1) : r * (q + 1) + (xcd - r) * q) + off; }
        const int nig = WGM * nN, gid = wgid / nig, fm = gid * WGM, gsz = (nM - fm) < WGM ? (nM - fm) : WGM;
        u.pm = fm + ((wgid % nig) % gsz); u.pn = (wgid % nig) / gsz; u.kind = 0; return true;
    }
    __device__ __forceinline__ void a_ready(const Unit&) const {}
    __device__ __forceinline__ void done(const Unit&) const {}
    static __device__ __forceinline__ bool keep_acc(const Unit&) { return false; }
};
struct PairOrder : StaticOrder {
    int a_off, b_off;
    __device__ bool next(int i, Unit& u) const { if (!StaticOrder::next(i >> 1, u)) return false; u.kind = i & 1; if (u.kind) { u.pm += a_off; u.pn += b_off; } return true; }
    static __device__ __forceinline__ bool keep_acc(const Unit& u) { return u.kind == 0; }
};
struct GroupOrder {
    static constexpr bool VAR_K = false;
    int np[8], pb[8]; int ncol, total, G, c;
    __device__ __forceinline__ void init(const unsigned* cnt, int ncol_, int G_, int c_) {
        int acc = 0;
#pragma unroll
        for (int e = 0; e < 8; ++e) { const int n = cnt ? (int)((__builtin_amdgcn_readfirstlane(__hip_atomic_load(cnt + 64 * e, __ATOMIC_RELAXED, __HIP_MEMORY_SCOPE_AGENT)) + 255u) >> 8) : (e == 0 ? NTOK / 256 : 0); np[e] = n; pb[e] = acc; acc += n; }
        ncol = ncol_; total = acc * ncol_; G = G_; c = c_;
    }
    __device__ __forceinline__ bool next(int i, Unit& u) const {
        const long L = (long)i * G + c; if (L >= total) return false;
        int wgid = (int)L; { const int q = total / NXCD, r = total % NXCD, xcd = wgid % NXCD, off = wgid / NXCD; wgid = (xcd < r ? xcd * (q + 1) : r * (q + 1) + (xcd - r) * q) + off; }
        int local = wgid, npe = 1, pbe = 0, ee = 0; bool found = false;
#pragma unroll
        for (int k = 0; k < 8; ++k) { const int n = np[k] * ncol; if (!found) { if (local < n) { found = true; npe = np[k]; pbe = pb[k]; ee = k; } else local -= n; } }
        const int j = local / npe, p = local - j * npe;
        u.pm = pbe + p; u.pn = ee * ncol + j; u.kind = 0; return true;
    }
    __device__ __forceinline__ void a_ready(const Unit&) const {}
    __device__ __forceinline__ void done(const Unit&) const {}
    static __device__ __forceinline__ bool keep_acc(const Unit&) { return false; }
};

__device__ __forceinline__ int moe_split_r(int P, int G) { return (G == 256 && P > 64) ? P - 64 : 0; }
template <int KT> struct DownOrderT {
    static constexpr bool VAR_K = true;
    static constexpr int ktiles = KT;
    int npf[8], npa[8], pb[8]; int nfull, total, psplit0, G, c;
    __device__ __forceinline__ void init(const unsigned* cnt, int G_, int c_) {
        int acc = 0;
#pragma unroll
        for (int e = 0; e < 8; ++e) { const int n = cnt ? (int)((__builtin_amdgcn_readfirstlane(__hip_atomic_load(cnt + 64 * e, __ATOMIC_RELAXED, __HIP_MEMORY_SCOPE_AGENT)) + 255u) >> 8) : (e == 0 ? NTOK / 256 : 0); npa[e] = n; pb[e] = acc; acc += n; }
        const int r = cnt ? moe_split_r(acc, G_) : 0; psplit0 = acc - r;
#pragma unroll
        for (int e = 0; e < 8; ++e) { int f = psplit0 - pb[e]; f = f < 0 ? 0 : f; npf[e] = f < npa[e] ? f : npa[e]; }
        nfull = psplit0 * 8; total = nfull + r * 32; G = G_; c = c_;
    }
    __device__ __forceinline__ bool next(int i, Unit& u) const {
        const long L = (long)i * G + c; if (L >= total) return false;
        if (L < nfull) {
            int wgid = (int)L; { const int q = nfull / NXCD, r = nfull % NXCD, xcd = wgid % NXCD, off = wgid / NXCD; wgid = (xcd < r ? xcd * (q + 1) : r * (q + 1) + (xcd - r) * q) + off; }
            int local = wgid, npe = 1, pbe = 0, ee = 0; bool found = false;
#pragma unroll
            for (int k = 0; k < 8; ++k) { const int n = npf[k] * 8; if (!found) { if (local < n) { found = true; npe = npf[k]; pbe = pb[k]; ee = k; } else local -= n; } }
            const int j = local / npe, p = local - j * npe;
            u.pm = pbe + p; u.pn = ee * 8 + j; u.kind = 0;
        } else {
            const int q = (int)L - nfull, panel = psplit0 + (q >> 5), rem = q & 31; int ee = 0;
#pragma unroll
            for (int k = 0; k < 8; ++k) if (panel >= pb[k] && panel < pb[k] + npa[k]) ee = k;
            const int sl = rem & 3;
            u.pm = panel; u.pn = ee * 8 + (rem >> 2); u.kind = 4 + sl;
        }
        return true;
    }
    static __device__ __forceinline__ int nt_of(const Unit& u) { return u.kind < 4 ? KT : (KT == 88 ? 22 : 12 - (u.kind & 2)); }
    static __device__ __forceinline__ int koff_of(const Unit& u) { const int sl = u.kind & 3; return u.kind < 4 ? 0 : BK * (KT == 88 ? 22 * sl : 12 * sl - (sl == 3 ? 2 : 0)); }
    __device__ __forceinline__ void a_ready(const Unit&) const {}
    __device__ __forceinline__ void done(const Unit&) const {}
    static __device__ __forceinline__ bool keep_acc(const Unit&) { return false; }
};


struct EpiIn {
    static constexpr bool PERM = true, AFTER_DRAIN = false, LDS_SCALES = true;
    __device__ __forceinline__ void scale_src(const Unit& u, const GAS float*& rp, const GAS float*& cp) const { rp = sa + u.pm * BM; cp = sb + u.pn * BM; }
    const GAS float* sa; const GAS float* sb;
    GAS bf16_t* qkvuv; GAS bf16_t* gab; GAS float* ksum; GAS f32x2* vgst;
#define EPIN_V(ai, bj, m, n) ((f32x4){(float)acc[ai][bj][m][n][0], (float)acc[ai][bj][m][n][1], (float)acc[ai][bj][m][n][2], (float)acc[ai][bj][m][n][3]} * sbv[bj][n] * rs[ai][m])
    static __device__ __forceinline__ unsigned q8x4(const f32x4 x) {
        unsigned b[4];
#pragma unroll
        for (int j = 0; j < 4; ++j) { const unsigned t = __float_as_uint(__builtin_fmaf(x[j], 255.0f, 8388608.0f)); b[j] = t > 0x4B000001u ? t : 0x4B000001u; }
        return __builtin_amdgcn_perm(b[1], b[0], 0x0c0c0400u) | (__builtin_amdgcn_perm(b[3], b[2], 0x0c0c0400u) << 16);
    }
    template <int ACT> __device__ __forceinline__ void body(const i32x4 (&acc)[2][2][4][2], GAS bf16_t* base, int ldc, int row0, int col0, const f32x4 (&sbv)[2][2], const float (&rs)[2][4], GAS f32x2* vg) const {
#pragma unroll
        for (int ai = 0; ai < 2; ++ai)
#pragma unroll
            for (int m = 0; m < 4; ++m) { GAS bf16_t* rowp = base + (size_t)(row0 + ai * HALF + m * 16) * ldc + col0;
                float st1 = 0.f, st2 = 0.f;
#pragma unroll
                for (int bj = 0; bj < 2; ++bj) { f32x4 v[2];
#pragma unroll
                    for (int n = 0; n < 2; ++n) { f32x4 x;
#pragma unroll
                        for (int j = 0; j < 4; ++j) { float t; asm volatile("v_cvt_f32_i32 %0, %1" : "=v"(t) : "v"(acc[ai][bj][m][n][j])); x[j] = t * sbv[bj][n][j] * rs[ai][m]; }
                        if (ACT == 2) {
#pragma unroll
                            for (int j = 0; j < 4; ++j) x[j] = __builtin_amdgcn_rcpf(1.0f + __builtin_amdgcn_exp2f(x[j])); }
                        else if (ACT == 1 || ACT == 3) {
#pragma unroll
                            for (int j = 0; j < 4; ++j) { const float xx = x[j]; const float p = __builtin_fmaf(xx * xx, -0.10294324f, -2.30220820f); x[j] = xx * __builtin_amdgcn_rcpf(1.0f + __builtin_amdgcn_exp2f(xx * p)); }
                            if (ACT == 3) {
#pragma unroll
                                for (int j = 0; j < 4; ++j) { st1 += x[j]; st2 = __builtin_fmaf(x[j], x[j], st2); } } }
                        v[n] = x; }
                    if (ACT == 2) { u32x2 w; w.x = q8x4(v[0]); w.y = q8x4(v[1]); *(GAS u32x2*)((GAS unsigned char*)base + (size_t)(row0 + ai * HALF + m * 16) * ldc + col0 + bj * HALF) = w; }
                    else { u32x4 w; w.x = cvt_pk_bf16(v[0][0], v[0][1]); w.y = cvt_pk_bf16(v[0][2], v[0][3]); w.z = cvt_pk_bf16(v[1][0], v[1][1]); w.w = cvt_pk_bf16(v[1][2], v[1][3]);
                        *(GAS u32x4*)(rowp + bj * HALF) = w; } }
                if (ACT == 3) { st1 += __shfl_xor(st1, 16); st1 += __shfl_xor(st1, 32); st2 += __shfl_xor(st2, 16); st2 += __shfl_xor(st2, 32);
                    if ((lane_id() & 48) == 0) vg[(size_t)(row0 + ai * HALF + m * 16) * 16] = (f32x2){st1, st2}; }
                __builtin_amdgcn_sched_barrier(0); }
    }
    __device__ __forceinline__ void operator()(const i32x4 (&acc)[2][2][4][2], const Unit& u, int wr, int wc, int fr, int fq, const LAS float* scl) const {
        const int pn = u.pn; GAS bf16_t* base; int ldc, colt;
        if (pn < 20) { base = qkvuv + (size_t)(pn >> 2) * ((size_t)NTOK * 1024); ldc = 1024; colt = (pn & 3) * 256; }
        else { const int q = pn - 20; base = (GAS bf16_t*)((GAS unsigned char*)gab + (size_t)(q >> 3) * ((size_t)NTOK * 2048)); ldc = 2048; colt = (q & 7) * 256; }
        const int row0 = u.pm * BM + wr * 64 + fr, col0 = colt + wc * 32 + 8 * fq;
        f32x4 sbv[2][2]; { const LAS float* sbp = scl + 256 + wc * 32 + 8 * fq;
#pragma unroll
            for (int bj = 0; bj < 2; ++bj)
#pragma unroll
                for (int n = 0; n < 2; ++n) sbv[bj][n] = *(const LAS f32x4*)(sbp + bj * HALF + 4 * n); }
        float rs[2][4];
#pragma unroll
        for (int ai = 0; ai < 2; ++ai)
#pragma unroll
            for (int m = 0; m < 4; ++m) rs[ai][m] = scl[wr * 64 + fr + ai * HALF + m * 16];
        if (pn >= 20) {
#pragma unroll
            for (int bj = 0; bj < 2; ++bj)
#pragma unroll
                for (int n = 0; n < 2; ++n) sbv[bj][n] *= -1.4426950408889634f;
            body<2>(acc, base, ldc, row0, col0, sbv, rs, nullptr); }
        else if (pn >= 16) body<3>(acc, base, ldc, row0, col0, sbv, rs, vgst + (pn - 16) * 4 + wc);
        else if (pn >= 12) body<1>(acc, base, ldc, row0, col0, sbv, rs, nullptr);
        else {
            if (pn >= 4 && pn < 8) {
#pragma unroll
                for (int bj = 0; bj < 2; ++bj)
#pragma unroll
                    for (int n = 0; n < 2; ++n) { f32x4 sv = (f32x4){0.f, 0.f, 0.f, 0.f};
#pragma unroll
                        for (int ai = 0; ai < 2; ++ai)
#pragma unroll
                            for (int m = 0; m < 4; ++m) {
#pragma unroll
                                for (int j = 0; j < 4; ++j) { float t; asm volatile("v_cvt_f32_i32 %0, %1" : "=v"(t) : "v"(acc[ai][bj][m][n][j])); sv[j] = __builtin_fmaf(t, rs[ai][m], sv[j]); } }
                        sv *= sbv[bj][n];
#pragma unroll
                        for (int j = 0; j < 4; ++j) { float t = sv[j]; t += __shfl_xor(t, 1); t += __shfl_xor(t, 2); t += __shfl_xor(t, 4); t += __shfl_xor(t, 8); sv[j] = t; }
                        if (fr == 0) *(GAS f32x4*)(ksum + ((size_t)u.pm * 2 + wr) * 1024 + col0 + bj * HALF + 4 * n) = sv; } }
            body<0>(acc, base, ldc, row0, col0, sbv, rs, nullptr); }
    }
};
#undef EPIN_V
struct EpiMrg {
    static constexpr bool PERM = true, AFTER_DRAIN = false, LDS_SCALES = false;
    const GAS unsigned char* ga; const GAS unsigned char* gb; GAS bf16_t* mrg;
    __device__ __forceinline__ void operator()(f32x4 (&acc)[2][2][4][2], const Unit& u, int wr, int wc, int fr, int fq) const {
        const int row0 = (u.pm & 31) * BM + wr * 64 + fr, col0 = (u.pn & 7) * BM + wc * 32 + 8 * fq;
#pragma unroll
        for (int ai = 0; ai < 2; ++ai)
#pragma unroll
            for (int m = 0; m < 4; ++m) { const size_t off = (size_t)(row0 + ai * HALF + m * 16) * DM + col0;
#pragma unroll
                for (int bj = 0; bj < 2; ++bj) { const size_t o = off + bj * HALF; const u32x2 g = *(const GAS u32x2*)(gb + o);
                    const f32x4 g0 = (f32x4){(float)((g.x >> 0) & 0xffu), (float)((g.x >> 8) & 0xffu), (float)((g.x >> 16) & 0xffu), (float)((g.x >> 24) & 0xffu)};
                    const f32x4 g1 = (f32x4){(float)((g.y >> 0) & 0xffu), (float)((g.y >> 8) & 0xffu), (float)((g.y >> 16) & 0xffu), (float)((g.y >> 24) & 0xffu)};
                    if (u.kind == 0) { const u32x2 a = *(const GAS u32x2*)(ga + o);
                        const f32x4 a0 = (f32x4){(float)((a.x >> 0) & 0xffu), (float)((a.x >> 8) & 0xffu), (float)((a.x >> 16) & 0xffu), (float)((a.x >> 24) & 0xffu)};
                        const f32x4 a1 = (f32x4){(float)((a.y >> 0) & 0xffu), (float)((a.y >> 8) & 0xffu), (float)((a.y >> 16) & 0xffu), (float)((a.y >> 24) & 0xffu)};
#pragma unroll
                        for (int j = 0; j < 4; ++j) { acc[ai][bj][m][0][j] *= a0[j] * __builtin_amdgcn_rcpf(g0[j]); acc[ai][bj][m][1][j] *= a1[j] * __builtin_amdgcn_rcpf(g1[j]); } }
                    else { const f32x4 r0 = acc[ai][bj][m][0] * (g0 * (1.0f / 255.0f)), r1 = acc[ai][bj][m][1] * (g1 * (1.0f / 255.0f));
                        u32x4 w; w.x = cvt_pk_bf16(r0[0], r0[1]); w.y = cvt_pk_bf16(r0[2], r0[3]); w.z = cvt_pk_bf16(r1[0], r1[1]); w.w = cvt_pk_bf16(r1[2], r1[3]);
                        *(GAS u32x4*)(mrg + o) = w; } } }
    }
};
template <bool RES_F32> struct EpiRes {
    static constexpr bool PERM = true, AFTER_DRAIN = false, LDS_SCALES = false;
    const GAS float* resf; const GAS bf16_t* resb; GAS bf16_t* out;
    __device__ __forceinline__ void operator()(const f32x4 (&acc)[2][2][4][2], const Unit& u, int wr, int wc, int fr, int fq) const {
        const int row0 = u.pm * BM + wr * 64 + fr, col0 = (u.pn & 7) * BM + wc * 32 + 8 * fq;
#pragma unroll
        for (int ai = 0; ai < 2; ++ai)
#pragma unroll
            for (int m = 0; m < 4; ++m) { const size_t off = (size_t)(row0 + ai * HALF + m * 16) * DM + col0;
#pragma unroll
                for (int bj = 0; bj < 2; ++bj) { const size_t o = off + bj * HALF; f32x4 r0, r1;
                    if (RES_F32) { r0 = *(const GAS f32x4*)(resf + o); r1 = *(const GAS f32x4*)(resf + o + 4); }
                    else { const u32x4 w = *(const GAS u32x4*)(resb + o); r0 = (f32x4){bflo(w.x), bfhi(w.x), bflo(w.y), bfhi(w.y)}; r1 = (f32x4){bflo(w.z), bfhi(w.z), bflo(w.w), bfhi(w.w)}; }
                    r0 += acc[ai][bj][m][0]; r1 += acc[ai][bj][m][1];
                    u32x4 w; w.x = cvt_pk_bf16(r0[0], r0[1]); w.y = cvt_pk_bf16(r0[2], r0[3]); w.z = cvt_pk_bf16(r1[0], r1[1]); w.w = cvt_pk_bf16(r1[2], r1[3]);
                    *(GAS u32x4*)(out + o) = w; } }
    }
};
struct EpiRes8 {
    static constexpr bool PERM = true, AFTER_DRAIN = false, LDS_SCALES = true;
    __device__ __forceinline__ void scale_src(const Unit& u, const GAS float*& rp, const GAS float*& cp) const { rp = sa + u.pm * BM; cp = sb + u.pn * BM; }
    const GAS float* sa; const GAS float* sb; GAS bf16_t* yp; int split_row0; GAS bf16_t* yb;
    __device__ __forceinline__ void operator()(const i32x4 (&acc)[2][2][4][2], const Unit& u, int wr, int wc, int fr, int fq, const LAS float* scl) const {
        const int row0 = u.pm * BM + wr * 64 + fr, col0 = (u.pn & 7) * BM + wc * 32 + 8 * fq;
        f32x4 sbv[2][2]; { const LAS float* sbp = scl + 256 + wc * 32 + 8 * fq;
#pragma unroll
            for (int bj = 0; bj < 2; ++bj)
#pragma unroll
                for (int n = 0; n < 2; ++n) sbv[bj][n] = *(const LAS f32x4*)(sbp + bj * HALF + 4 * n); }
        const int sl = u.kind & 3;
#pragma unroll
        for (int ai = 0; ai < 2; ++ai)
#pragma unroll
            for (int m = 0; m < 4; ++m) { const int r = row0 + ai * HALF + m * 16; const float s = scl[wr * 64 + fr + ai * HALF + m * 16];
                GAS bf16_t* dst = sl == 0 ? yb + (size_t)r * DM + col0 : yp + ((size_t)(sl - 1) * 2048 + (size_t)(r - split_row0)) * DM + col0;
#pragma unroll
                for (int bj = 0; bj < 2; ++bj) { f32x4 v[2];
#pragma unroll
                    for (int n = 0; n < 2; ++n) v[n] = (f32x4){(float)acc[ai][bj][m][n][0], (float)acc[ai][bj][m][n][1], (float)acc[ai][bj][m][n][2], (float)acc[ai][bj][m][n][3]} * sbv[bj][n] * s;
                    u32x4 w; w.x = cvt_pk_bf16(v[0][0], v[0][1]); w.y = cvt_pk_bf16(v[0][2], v[0][3]); w.z = cvt_pk_bf16(v[1][0], v[1][1]); w.w = cvt_pk_bf16(v[1][2], v[1][3]);
                    *(GAS u32x4*)(dst + bj * HALF) = w; } }
    }
};
struct EpiResX8 {
    static constexpr bool PERM = true, AFTER_DRAIN = false, LDS_SCALES = true;
    __device__ __forceinline__ void scale_src(const Unit& u, const GAS float*& rp, const GAS float*& cp) const { rp = sa + u.pm * BM; cp = sb + u.pn * BM; }
    const GAS float* sa; const GAS float* sb; GAS bf16_t* x;
    __device__ __forceinline__ void operator()(const i32x4 (&acc)[2][2][4][2], const Unit& u, int wr, int wc, int fr, int fq, const LAS float* scl) const {
        const int row0 = u.pm * BM + wr * 64 + fr, col0 = (u.pn & 7) * BM + wc * 32 + 8 * fq;
        f32x4 sbv[2][2]; { const LAS float* sbp = scl + 256 + wc * 32 + 8 * fq;
#pragma unroll
            for (int bj = 0; bj < 2; ++bj)
#pragma unroll
                for (int n = 0; n < 2; ++n) sbv[bj][n] = *(const LAS f32x4*)(sbp + bj * HALF + 4 * n); }
#pragma unroll
        for (int ai = 0; ai < 2; ++ai)
#pragma unroll
            for (int m = 0; m < 4; ++m) { const int r = row0 + ai * HALF + m * 16; const float s = scl[wr * 64 + fr + ai * HALF + m * 16]; GAS bf16_t* xp = x + (size_t)r * DM + col0;
#pragma unroll
                for (int bj = 0; bj < 2; ++bj) { const u32x4 w0 = *(const GAS u32x4*)(xp + bj * HALF);
                    f32x4 r0 = (f32x4){bflo(w0.x), bfhi(w0.x), bflo(w0.y), bfhi(w0.y)}, r1 = (f32x4){bflo(w0.z), bfhi(w0.z), bflo(w0.w), bfhi(w0.w)};
                    r0 += (f32x4){(float)acc[ai][bj][m][0][0], (float)acc[ai][bj][m][0][1], (float)acc[ai][bj][m][0][2], (float)acc[ai][bj][m][0][3]} * sbv[bj][0] * s;
                    r1 += (f32x4){(float)acc[ai][bj][m][1][0], (float)acc[ai][bj][m][1][1], (float)acc[ai][bj][m][1][2], (float)acc[ai][bj][m][1][3]} * sbv[bj][1] * s;
                    u32x4 w; w.x = cvt_pk_bf16(r0[0], r0[1]); w.y = cvt_pk_bf16(r0[2], r0[3]); w.z = cvt_pk_bf16(r1[0], r1[1]); w.w = cvt_pk_bf16(r1[2], r1[3]);
                    *(GAS u32x4*)(xp + bj * HALF) = w; } }
    }
};
struct EpiGU {
    static constexpr bool PERM = true, AFTER_DRAIN = false, LDS_SCALES = false;
    GAS bf16_t* act; int ncol;
    __device__ __forceinline__ void operator()(const f32x4 (&acc)[2][2][4][2], const Unit& u, int wr, int wc, int fr, int fq) const {
        const int jt = u.pn % ncol; const int row0 = u.pm * BM + wr * 64 + fr, col0 = jt * 128 + wc * 32 + 8 * fq;
#pragma unroll
        for (int ai = 0; ai < 2; ++ai)
#pragma unroll
            for (int m = 0; m < 4; ++m) { GAS bf16_t* rowp = act + (size_t)(row0 + ai * HALF + m * 16) * FF + col0;
                f32x4 v0, v1;
#pragma unroll
                for (int j = 0; j < 4; ++j) { v0[j] = silu_f(acc[ai][0][m][0][j]) * acc[ai][1][m][0][j]; v1[j] = silu_f(acc[ai][0][m][1][j]) * acc[ai][1][m][1][j]; }
                u32x4 w; w.x = cvt_pk_bf16(v0[0], v0[1]); w.y = cvt_pk_bf16(v0[2], v0[3]); w.z = cvt_pk_bf16(v1[0], v1[1]); w.w = cvt_pk_bf16(v1[2], v1[3]);
                *(GAS u32x4*)rowp = w; }
    }
};

struct EpiGU8 {
    static constexpr bool PERM = true, AFTER_DRAIN = false, LDS_SCALES = true;
    __device__ __forceinline__ void scale_src(const Unit& u, const GAS float*& rp, const GAS float*& cp) const { rp = sa + u.pm * BM; cp = sb + u.pn * BM; }
    GAS bf16_t* act; int ncol; const GAS float* sa; const GAS float* sb;
    __device__ __forceinline__ void operator()(const i32x4 (&acc)[2][2][4][2], const Unit& u, int wr, int wc, int fr, int fq, const LAS float* scl) const {
        const int jt = u.pn % ncol; const int row0 = u.pm * BM + wr * 64 + fr, col0 = jt * 128 + wc * 32 + 8 * fq;
        const LAS float* sbp = scl + 256 + wc * 32 + 8 * fq;
        const f32x4 sg0 = *(const LAS f32x4*)sbp * -1.4426950408889634f, sg1 = *(const LAS f32x4*)(sbp + 4) * -1.4426950408889634f, su0 = *(const LAS f32x4*)(sbp + HALF) * -0.6931471805599453f, su1 = *(const LAS f32x4*)(sbp + HALF + 4) * -0.6931471805599453f;
#pragma unroll
        for (int ai = 0; ai < 2; ++ai)
#pragma unroll
            for (int m = 0; m < 4; ++m) { const int r = row0 + ai * HALF + m * 16; GAS bf16_t* rowp = act + (size_t)r * FF + col0; const float ra = scl[wr * 64 + fr + ai * HALF + m * 16];
                f32x4 v0, v1;
#pragma unroll
                for (int j = 0; j < 4; ++j) { const float g0 = (float)acc[ai][0][m][0][j] * (ra * sg0[j]), g1 = (float)acc[ai][0][m][1][j] * (ra * sg1[j]);
                    v0[j] = g0 * __builtin_amdgcn_rcpf(1.0f + __builtin_amdgcn_exp2f(g0)) * ((float)acc[ai][1][m][0][j] * (ra * su0[j]));
                    v1[j] = g1 * __builtin_amdgcn_rcpf(1.0f + __builtin_amdgcn_exp2f(g1)) * ((float)acc[ai][1][m][1][j] * (ra * su1[j])); }
                u32x4 w; w.x = cvt_pk_bf16(v0[0], v0[1]); w.y = cvt_pk_bf16(v0[2], v0[3]); w.z = cvt_pk_bf16(v1[0], v1[1]); w.w = cvt_pk_bf16(v1[2], v1[3]);
                *(GAS u32x4*)rowp = w; }
    }
};

template <bool I8> struct AccT { typedef f32x4 t; };
template <> struct AccT<true> { typedef i32x4 t; };
__device__ __forceinline__ f32x4 mma_op(bf16x8 b, bf16x8 a, f32x4 c) { return __builtin_amdgcn_mfma_f32_16x16x32_bf16(b, a, c, 0, 0, 0); }
__device__ __forceinline__ i32x4 mma_op(bf16x8 b, bf16x8 a, i32x4 c) { return __builtin_amdgcn_mfma_i32_16x16x64_i8(__builtin_bit_cast(i32x4, b), __builtin_bit_cast(i32x4, a), c, 0, 0, 0); }
template <class Epi, class Sched, bool ALIGN_EPI = false, bool SP2 = false, bool I8 = false>
__device__ __forceinline__ void gemm_phase(LAS unsigned char* lds, const Gemm g, const Sched& S, const Epi& E, int tid) {
    asm volatile("" : "+v"(tid));
    const int wid = __builtin_amdgcn_readfirstlane(tid >> 6), lane = tid & 63, wr = wid >> 2, wc = wid & 3, fr = lane & 15, fq = lane >> 4;
    const int K = g.K, nt = K / BK, lda = g.lda ? g.lda : K, ldb = g.ldb ? g.ldb : K;
    unsigned voffA[2], voffB[2];
#pragma unroll
    for (int i = 0; i < 2; ++i) { int R, C; stage_rc(tid * 16 + i * 8192, R, C); const int Rb = Epi::PERM ? ((R & ~31) + perm32(R & 31)) : R;
        voffA[i] = (unsigned)(R * lda + C) * 2u; voffB[i] = (unsigned)(Rb * ldb + C) * 2u; }
    const size_t kstep = (size_t)(BK * 2);
    const size_t hstep = (size_t)HALF * lda * 2, hstepB = (size_t)HALF * ldb * 2;
    const size_t tstep = 2 * hstep, tstepB = 2 * hstepB;
    const unsigned ldsw = (unsigned)wid * 1024u;
    const int aoff = lds_byte(wr * 64 + fr, fq * 8), boff = lds_byte(wc * 32 + fr, fq * 8);
#define PG8_SA(b, h) (((b) * 2 + (h)) * HTB)
#define PG8_SB(b, h) ((4 + (b) * 2 + (h)) * HTB)
#define PG8_STAGE(bufoff, gbase, voff) do { _Pragma("unroll") for (int _i = 0; _i < 2; ++_i) \
        __builtin_amdgcn_global_load_lds((const unsigned*)((const char*)(gbase) + (voff)[_i]), (LAS unsigned*)(lds + (bufoff) + ldsw + _i * 8192), 16, 0, 0); } while (0)
#define PG8_LDA(dst, b, h) do { _Pragma("unroll") for (int m = 0; m < 4; ++m) _Pragma("unroll") for (int k = 0; k < 2; ++k) dst[m][k] = *(const LAS bf16x8*)(lds + PG8_SA(b, h) + aoff + m * 2048 + k * 1024); } while (0)
#define PG8_LDB(dst, b, h) do { _Pragma("unroll") for (int n = 0; n < 2; ++n) _Pragma("unroll") for (int k = 0; k < 2; ++k) dst[n][k] = *(const LAS bf16x8*)(lds + PG8_SB(b, h) + boff + n * 2048 + k * 1024); } while (0)
#define PG8_MMA(ai, bj, At, Bt) do { __builtin_amdgcn_s_setprio(1); _Pragma("unroll") for (int m = 0; m < 4; ++m) _Pragma("unroll") for (int n = 0; n < 2; ++n) _Pragma("unroll") for (int k = 0; k < 2; ++k) \
        acc[ai][bj][m][n] = mma_op(Bt[n][k], At[m][k], acc[ai][bj][m][n]); __builtin_amdgcn_s_setprio(0); } while (0)
#define PG8_WAIT_V(n) asm volatile("s_waitcnt vmcnt(" #n ")" ::: "memory")
#define PG8_WAIT_L(n) asm volatile("s_waitcnt lgkmcnt(" #n ")" ::: "memory")
#define PG8_BAR __builtin_amdgcn_s_barrier()
#define PG8_SCHED __builtin_amdgcn_sched_barrier(0)
    Unit cur, nxt; int ui = 0;
    if (!S.next(0, cur)) return;
#define PG8_SCALES(uu, par) do { if constexpr (Epi::LDS_SCALES) { const GAS float* rp_; const GAS float* cp_; E.scale_src(uu, rp_, cp_); \
        __builtin_amdgcn_global_load_lds((const unsigned*)((wid < 4 ? rp_ : cp_ - 256) + wid * 64 + lane), (LAS unsigned*)(lds + SCL_OFF + (par) * 2048 + wid * 256), 4, 0, 0); } } while (0)
    typedef typename AccT<I8>::t acc_t;
    acc_t acc[2][2][4][2];
#pragma unroll
    for (int a = 0; a < 2; ++a)
#pragma unroll
        for (int b = 0; b < 2; ++b)
#pragma unroll
            for (int m = 0; m < 4; ++m)
#pragma unroll
                for (int n = 0; n < 2; ++n) acc[a][b][m][n] = (acc_t){0, 0, 0, 0};
    bf16x8 At[4][2], B0[2][2], B1[2][2];
    const char* cA = (const char*)g.A + (size_t)cur.pm * tstep; const char* cB = (const char*)g.Bt + (size_t)cur.pn * tstepB;
    int unt = nt;
    if constexpr (Sched::VAR_K) { const int ko = Sched::koff_of(cur); cA += (size_t)ko * 2; cB += (size_t)ko * 2; unt = Sched::nt_of(cur); }
    S.a_ready(cur);
    PG8_SCALES(cur, 0);
    if constexpr (SP2) {
        PG8_STAGE(PG8_SB(0, 0), cB, voffB); PG8_STAGE(PG8_SB(0, 1), cB + hstepB, voffB); PG8_STAGE(PG8_SA(0, 0), cA, voffA); PG8_STAGE(PG8_SA(0, 1), cA + hstep, voffA);
        if (wr == 1) PG8_BAR;
        PG8_WAIT_V(2); PG8_BAR;
        PG8_STAGE(PG8_SB(1, 0), cB + kstep, voffB); PG8_STAGE(PG8_SA(1, 0), cA + kstep, voffA); PG8_STAGE(PG8_SB(1, 1), cB + hstepB + kstep, voffB);
        PG8_WAIT_V(6); PG8_BAR;
    } else {
        PG8_STAGE(PG8_SB(0, 0), cB, voffB); PG8_STAGE(PG8_SA(0, 0), cA, voffA); PG8_STAGE(PG8_SB(0, 1), cB + hstepB, voffB); PG8_STAGE(PG8_SA(0, 1), cA + hstep, voffA);
        if (wr == 1) PG8_BAR;
        PG8_WAIT_V(4); PG8_BAR;
        PG8_STAGE(PG8_SB(1, 0), cB + kstep, voffB); PG8_STAGE(PG8_SA(1, 0), cA + kstep, voffA); PG8_STAGE(PG8_SB(1, 1), cB + hstepB + kstep, voffB);
        PG8_WAIT_V(6); PG8_BAR;
    }
    for (;;) {
        const bool has_next = S.next(ui + 1, nxt);
        const char* nA = has_next ? (const char*)g.A + (size_t)nxt.pm * tstep : cA; const char* nB = has_next ? (const char*)g.Bt + (size_t)nxt.pn * tstepB : cB;
        if constexpr (Sched::VAR_K) { if (has_next) { const int ko = Sched::koff_of(nxt); nA += (size_t)ko * 2; nB += (size_t)ko * 2; } }
        for (int t = 0; t < unt; t += 2) {
            const bool last = (t == unt - 2);
            const char* a1 = cA + (size_t)(t + 1) * kstep;
            const char* a2 = last ? nA : cA + (size_t)(t + 2) * kstep; const char* b2 = last ? nB : cB + (size_t)(t + 2) * kstep;
            const char* a3 = a2 + kstep; const char* b3 = b2 + kstep;
            if (last && has_next) S.a_ready(nxt);
            if constexpr (SP2) {
            PG8_LDB(B0, 0, 0); PG8_LDB(B1, 0, 1); PG8_SCHED; PG8_LDA(At, 0, 0); PG8_STAGE(PG8_SA(1, 1), a1 + hstep, voffA);
            PG8_WAIT_V(8); PG8_WAIT_L(0); PG8_BAR; PG8_MMA(0, 0, At, B0); PG8_MMA(0, 1, At, B1); PG8_BAR; PG8_SCHED;
            PG8_LDA(At, 0, 1); PG8_STAGE(PG8_SB(0, 0), b2, voffB); PG8_STAGE(PG8_SB(0, 1), b2 + hstepB, voffB); PG8_STAGE(PG8_SA(0, 0), a2, voffA);
            PG8_WAIT_V(8); PG8_WAIT_L(0); PG8_BAR; PG8_MMA(1, 0, At, B0); PG8_MMA(1, 1, At, B1); PG8_BAR; PG8_SCHED;
            PG8_LDB(B0, 1, 0); PG8_LDB(B1, 1, 1); PG8_SCHED; PG8_LDA(At, 1, 0); PG8_STAGE(PG8_SA(0, 1), a2 + hstep, voffA);
            PG8_WAIT_V(8); PG8_WAIT_L(0); PG8_BAR; PG8_MMA(0, 0, At, B0); PG8_MMA(0, 1, At, B1); PG8_BAR; PG8_SCHED;
            PG8_LDA(At, 1, 1); PG8_STAGE(PG8_SB(1, 0), b3, voffB); PG8_STAGE(PG8_SB(1, 1), b3 + hstepB, voffB); PG8_STAGE(PG8_SA(1, 0), a3, voffA);
            PG8_WAIT_V(8); PG8_WAIT_L(0); PG8_BAR; PG8_MMA(1, 0, At, B0); PG8_MMA(1, 1, At, B1); PG8_BAR; PG8_SCHED;
            } else {
            PG8_LDB(B0, 0, 0); PG8_SCHED; PG8_LDA(At, 0, 0); PG8_STAGE(PG8_SA(1, 1), a1 + hstep, voffA);
            PG8_WAIT_L(8); PG8_BAR; PG8_WAIT_L(0); PG8_MMA(0, 0, At, B0); PG8_BAR; PG8_SCHED;
            PG8_LDB(B1, 0, 1); PG8_STAGE(PG8_SB(0, 0), b2, voffB);
            PG8_BAR; PG8_WAIT_L(0); PG8_MMA(0, 1, At, B1); PG8_BAR;
            PG8_LDA(At, 0, 1); PG8_STAGE(PG8_SA(0, 0), a2, voffA);
            PG8_BAR; PG8_WAIT_L(0); PG8_MMA(1, 0, At, B0); PG8_BAR; PG8_SCHED;
            PG8_STAGE(PG8_SB(0, 1), b2 + hstepB, voffB);
            PG8_WAIT_V(6); PG8_BAR; PG8_MMA(1, 1, At, B1); PG8_BAR;
            PG8_LDB(B0, 1, 0); PG8_SCHED; PG8_LDA(At, 1, 0); PG8_STAGE(PG8_SA(0, 1), a2 + hstep, voffA);
            PG8_WAIT_L(8); PG8_BAR; PG8_WAIT_L(0); PG8_MMA(0, 0, At, B0); PG8_BAR; PG8_SCHED;
            PG8_LDB(B1, 1, 1); PG8_STAGE(PG8_SB(1, 0), b3, voffB);
            PG8_BAR; PG8_WAIT_L(0); PG8_MMA(0, 1, At, B1); PG8_BAR;
            PG8_LDA(At, 1, 1); PG8_STAGE(PG8_SA(1, 0), a3, voffA);
            PG8_BAR; PG8_WAIT_L(0); PG8_MMA(1, 0, At, B0); PG8_BAR; PG8_SCHED;
            PG8_STAGE(PG8_SB(1, 1), b3 + hstepB, voffB);
            PG8_WAIT_V(6); PG8_BAR; PG8_MMA(1, 1, At, B1); PG8_BAR;
            }
        }
        if constexpr (ALIGN_EPI) { if (wr == 0) PG8_BAR; }
        if constexpr (Epi::LDS_SCALES) { E(acc, cur, wr, wc, fr, fq, (const LAS float*)(lds + SCL_OFF + (ui & 1) * 2048)); S.done(cur); }
        else if constexpr (!Epi::AFTER_DRAIN) { E(acc, cur, wr, wc, fr, fq); S.done(cur); }
        if (!has_next) break;
        if (!Sched::keep_acc(cur)) {
#pragma unroll
        for (int a = 0; a < 2; ++a)
#pragma unroll
            for (int b = 0; b < 2; ++b)
#pragma unroll
                for (int m = 0; m < 4; ++m)
#pragma unroll
                    for (int n = 0; n < 2; ++n) acc[a][b][m][n] = (acc_t){0, 0, 0, 0};
        }
        cur = nxt; cA = nA; cB = nB; ++ui; if constexpr (Sched::VAR_K) unt = Sched::nt_of(cur);
        if constexpr (ALIGN_EPI) { if (wr == 1) PG8_BAR; }
        PG8_SCALES(cur, ui & 1);
    }
    PG8_WAIT_V(0);
    if constexpr (!ALIGN_EPI) { if (wr == 0) PG8_BAR; }
    PG8_BAR;
#undef PG8_SCALES
#undef PG8_SA
#undef PG8_SB
#undef PG8_STAGE
#undef PG8_LDA
#undef PG8_LDB
#undef PG8_MMA
#undef PG8_WAIT_V
#undef PG8_WAIT_L
#undef PG8_BAR
#undef PG8_SCHED
}
}

namespace att {
constexpr int D = 128, PITCH = 1024, NW = 8, QBLK = 32, KVBLK = 64, QB = NW * QBLK;
constexpr int SHM_V = KVBLK * D * 2, SHM_K = KVBLK * D * 2;
constexpr int ATT_LDS = 2 * SHM_V + 2 * SHM_K + NW * 64 * 4;
constexpr int KMEAN_OFF = ATT_LDS;
constexpr int PART_OFF = KMEAN_OFF + 4096;
constexpr float SCALE = 0.08838834764831845f;
constexpr float THR = 8.f;
constexpr int WBIG = 1 << 30;
#define KSWZ(row, colB) ((row) * 256 + ((colB) ^ (((row) & 7) << 4)))
#define SBAR() __builtin_amdgcn_sched_barrier(0)
__device__ __forceinline__ int v_st(int k, int c) { const int kk = (k & ~0xC) | ((k & 4) << 1) | ((k & 8) >> 1); return ((kk >> 3) * 4 + (c >> 5)) * 512 + ((kk & 7) * 32 + (c & 31)) * 2; }
__device__ __forceinline__ int v_rd_base(int lane) { return ((lane & 3) << 3) | (((lane >> 2) & 3) << 6) | (((lane >> 4) & 1) << 5) | (((lane >> 5) & 1) << 8); }
constexpr int v_rd_off(int d0, int ks, int half) { return d0 * 512 + ks * 4096 + half * 2048; }
__device__ __forceinline__ int crow(int r, int hi) { return (r & 3) + 8 * (r >> 2) + 4 * hi; }
__device__ __forceinline__ unsigned cvtpk(float lo, float hi) { unsigned r; asm volatile("v_cvt_pk_bf16_f32 %0, %1, %2" : "=v"(r) : "v"(lo), "v"(hi)); return r; }
__device__ __forceinline__ bf16x8 load8(const GAS bf16_t* p) { return *(const GAS bf16x8*)p; }
__device__ __forceinline__ void mask_tile(f32x16& p0, f32x16& p1, int dq, unsigned W) {
    const float NEG = -__builtin_inff();
#pragma unroll
    for (int r = 0; r < 16; ++r) {
        const int c = (r & 3) + 8 * (r >> 2);
        if ((unsigned)(dq - c) >= W) p0[r] = NEG;
        if ((unsigned)(dq - c - 32) >= W) p1[r] = NEG;
    }
}
__device__ __forceinline__ void partialSM(f32x16& p0, f32x16& p1, float& m_reg, float& mn, float& alpha) {
    float pmax = p0[0]; for (int r = 1; r < 16; ++r) pmax = fmaxf(pmax, p0[r]); for (int r = 0; r < 16; ++r) pmax = fmaxf(pmax, p1[r]);
    { auto rr = __builtin_amdgcn_permlane32_swap(__float_as_uint(pmax), __float_as_uint(pmax), false, false);
      pmax = fmaxf(__uint_as_float(rr[0]), __uint_as_float(rr[1])); }
    constexpr float C2 = 1.4426950408889634f * SCALE;
    if (__builtin_expect(__all((pmax - m_reg) * SCALE <= THR), 1)) { mn = m_reg; alpha = 1.f; }
    else { mn = fmaxf(m_reg, pmax); alpha = __builtin_amdgcn_exp2f((m_reg - mn) * C2); m_reg = mn; }
    const float mnL = -mn * C2;
    for (int r = 0; r < 16; ++r) p0[r] = fmaf(p0[r], C2, mnL); for (int r = 0; r < 16; ++r) p1[r] = fmaf(p1[r], C2, mnL);
    for (int r = 0; r < 16; ++r) p0[r] = __builtin_amdgcn_exp2f(p0[r]);
}
__device__ __forceinline__ void finishSM(f32x16& p0, f32x16& p1, float alpha, float& l_reg, bf16x8& pa0, bf16x8& pa1, bf16x8& pa2, bf16x8& pa3) {
    for (int r = 0; r < 16; ++r) p1[r] = __builtin_amdgcn_exp2f(p1[r]);
    float ps = 0; for (int r = 0; r < 16; ++r) ps += p0[r]; for (int r = 0; r < 16; ++r) ps += p1[r];
    { auto rr = __builtin_amdgcn_permlane32_swap(__float_as_uint(ps), __float_as_uint(ps), false, false);
      ps = __uint_as_float(rr[0]) + __uint_as_float(rr[1]); }
    l_reg = l_reg * alpha + ps;
#define PK4(P, B_, OUT) do { unsigned a0 = cvtpk(P[B_+0], P[B_+1]), a1 = cvtpk(P[B_+2], P[B_+3]);                          \
        unsigned b0 = cvtpk(P[B_+4], P[B_+5]), b1 = cvtpk(P[B_+6], P[B_+7]);                                             \
        auto r0 = __builtin_amdgcn_permlane32_swap(a0, b0, false, false); auto r1 = __builtin_amdgcn_permlane32_swap(a1, b1, false, false); \
        u32x4 w = {r0[0], r1[0], r0[1], r1[1]}; OUT = *reinterpret_cast<bf16x8*>(&w); } while (0)
    PK4(p0, 0, pa0); PK4(p0, 8, pa1); PK4(p1, 0, pa2); PK4(p1, 8, pa3);
#undef PK4
}
template <int KB>
__device__ __forceinline__ void qkt(f32x16& p0, f32x16& p1, const char* K_lds, int r32, int hi, const bf16x8* qr) {
    p0 = f32x16{}; p1 = f32x16{};
    const char* kb[4];
#pragma unroll
    for (int dd = 0; dd < 4; ++dd) kb[dd] = K_lds + KB * SHM_K + KSWZ(r32, (dd * 16 + hi * 8) * 2);
#pragma unroll
    for (int d0 = 0; d0 < 8; ++d0) { const char* a = kb[d0 & 3] + (d0 >> 2) * 128;
        bf16x8 b0 = *reinterpret_cast<const bf16x8*>(a);
        bf16x8 b1 = *reinterpret_cast<const bf16x8*>(a + 32 * 256);
        p0 = __builtin_amdgcn_mfma_f32_32x32x16_bf16(b0, qr[d0], p0, 0, 0, 0);
        p1 = __builtin_amdgcn_mfma_f32_32x32x16_bf16(b1, qr[d0], p1, 0, 0, 0); }
}
template <int VB>
__device__ __forceinline__ void pv_tile(f32x16* o, int vb0, bf16x8 pa0, bf16x8 pa1, bf16x8 pa2, bf16x8 pa3) {
#define TRRD(dst, off) asm volatile("ds_read_b64_tr_b16 %0, %1 offset:%2" : "=&v"(dst) : "v"(vb0), "i"(off) : "memory")
#define PV_D0(d0) do { s16x4 l0, l1, l2, l3, h0, h1, h2, h3; constexpr int b_ = VB * SHM_V + v_rd_off(d0, 0, 0); \
        TRRD(l0, b_); TRRD(h0, b_ + 2048); TRRD(l1, b_ + 4096); TRRD(h1, b_ + 6144); TRRD(l2, b_ + 8192); TRRD(h2, b_ + 10240); TRRD(l3, b_ + 12288); TRRD(h3, b_ + 14336); \
        asm volatile("s_waitcnt lgkmcnt(0)" ::: "memory"); SBAR();   \
        o[d0] = __builtin_amdgcn_mfma_f32_32x32x16_bf16(pa0, (bf16x8){l0[0], l0[1], l0[2], l0[3], h0[0], h0[1], h0[2], h0[3]}, o[d0], 0, 0, 0);   \
        o[d0] = __builtin_amdgcn_mfma_f32_32x32x16_bf16(pa1, (bf16x8){l1[0], l1[1], l1[2], l1[3], h1[0], h1[1], h1[2], h1[3]}, o[d0], 0, 0, 0);   \
        o[d0] = __builtin_amdgcn_mfma_f32_32x32x16_bf16(pa2, (bf16x8){l2[0], l2[1], l2[2], l2[3], h2[0], h2[1], h2[2], h2[3]}, o[d0], 0, 0, 0);   \
        o[d0] = __builtin_amdgcn_mfma_f32_32x32x16_bf16(pa3, (bf16x8){l3[0], l3[1], l3[2], l3[3], h3[0], h3[1], h3[2], h3[3]}, o[d0], 0, 0, 0); } while (0)
    PV_D0(0); PV_D0(1); PV_D0(2); PV_D0(3);
#undef PV_D0
#undef TRRD
}
struct BlockRef { const GAS bf16_t* Q; const GAS bf16_t* K; const GAS bf16_t* V; GAS bf16_t* O; int P0; };
struct Seam { bf16x8 qr[8]; bf16x8 st_v0, st_v1, st_k0, st_k1; };
#define ROW(p, k0, rr) ((p) + (size_t)((k0) + (rr)) * PITCH + sc)
#define VMW() asm volatile("s_waitcnt vmcnt(0)" ::: "memory")
#define VMWN(n) asm volatile("s_waitcnt vmcnt(%0)" :: "i"(n) : "memory")
#define SLOAD_H(Kp, Vp, k0) do { S.st_v0 = load8(ROW(Vp, k0, sr)); S.st_v1 = load8(ROW(Vp, k0, 32 + sr));              \
                         S.st_k0 = load8(ROW(Kp, k0, sr)); S.st_k1 = load8(ROW(Kp, k0, 32 + sr)); } while (0)
#define SWRITE_HK(bf) do { *(bf16x8*)(K_lds + (bf) * SHM_K + kws) = S.st_k0; *(bf16x8*)(K_lds + (bf) * SHM_K + kws + 32 * 256) = S.st_k1; } while (0)
#define SWRITE_HV(bf) do { *(bf16x8*)(V_lds + (bf) * SHM_V + vst0) = S.st_v0; *(bf16x8*)(V_lds + (bf) * SHM_V + vst1) = S.st_v1; } while (0)
#define SWRITE_H(bf) do { SWRITE_HV(bf); SWRITE_HK(bf); } while (0)
__device__ __forceinline__ void attn_prime(const BlockRef& cur, char* lds, Seam& S, const int tid) {
    const int wid = __builtin_amdgcn_readfirstlane(tid >> 6), lane = tid & 63, r32 = lane & 31, hi = lane >> 5;
    const int sr = tid >> 4, sc = (tid & 15) * 8, kws = KSWZ(sr, sc * 2); char* K_lds = lds + 2 * SHM_V;
    const int kb0 = 0;
    for (int d0 = 0; d0 < 8; ++d0) S.qr[d0] = load8(cur.Q + (size_t)(wid * QBLK + r32) * PITCH + d0 * 16 + hi * 8);
    SLOAD_H(cur.K, cur.V, kb0); VMW(); SWRITE_HK(0);
    __syncthreads();
}
__device__ __forceinline__ void attn_block(const BlockRef& cur, const BlockRef& nxt, char* lds, Seam& S, unsigned selmask, const int tid) {
    const int W = WBIG;
    const int wid = __builtin_amdgcn_readfirstlane(tid >> 6), lane = tid & 63, r32 = lane & 31, hi = lane >> 5;
    const int j_lo = 0;
    const int j_hi = (cur.P0 + QB - 1) / KVBLK + 1;
    const int NT = j_hi - j_lo;
    const int kbn = 0;
    const int qlo = cur.P0 + wid * QBLK, qm = qlo + r32 - 4 * hi;
    char* V_lds = lds; char* K_lds = lds + 2 * SHM_V;
    float* ws = (float*)(lds + 2 * SHM_V + 2 * SHM_K) + wid * 64; float* li_l = ws, * al_l = ws + 32;
    float m_reg = -1e30f, l_reg = 0; f32x16 o[4] = {};
    const int sr = tid >> 4, sc = (tid & 15) * 8, vst0 = v_st(sr, sc), vst1 = v_st(32 + sr, sc), kws = KSWZ(sr, sc * 2);
    const int vb0 = (int)(uintptr_t)V_lds + v_rd_base(lane);
    const GAS bf16_t* Kh = cur.K; const GAS bf16_t* Vh = cur.V;
#define RESC(a) do { if (__any((a) < 1.f)) { if (hi == 0) al_l[r32] = (a); asm volatile("s_waitcnt lgkmcnt(0)" ::: "memory");              \
                     for (int d_ = 0; d_ < 4; ++d_) for (int r = 0; r < 16; ++r) o[d_][r] *= al_l[crow(r, hi)]; } } while (0)
#define KBASE(t) ((j_lo + (t)) * KVBLK)
#define MASKT(P0_, P1_, t) do { const int kb_ = KBASE(t); if (kb_ + KVBLK - 1 > qlo) mask_tile(P0_, P1_, qm - kb_, (unsigned)W); \
        if (kb_ < cur.P0) { const bool keep_ = ((selmask >> (kb_ >> 8)) & 1u) != 0u; const float NEG_ = -__builtin_inff(); \
            _Pragma("unroll") for (int r_ = 0; r_ < 16; ++r_) { P0_[r_] = keep_ ? P0_[r_] : NEG_; P1_[r_] = keep_ ? P1_[r_] : NEG_; } } } while (0)
    constexpr int NQL = 8;
#define SEAM_K0() do { VMWN(NQL); SWRITE_HK(0); SBAR(); } while (0)
    f32x16 pA0, pA1, pB0, pB1; float mnA, mnB, alA, alB; bf16x8 pa0, pa1, pa2, pa3;
    SWRITE_HV(0); SBAR();
    if (NT > 1) { SLOAD_H(Kh, Vh, KBASE(1)); }
    SBAR(); qkt<0>(pA0, pA1, K_lds, r32, hi, S.qr);
    MASKT(pA0, pA1, 0); partialSM(pA0, pA1, m_reg, mnA, alA);
    if (NT > 1) { VMW(); SWRITE_H(1); }
    __syncthreads();
#define HALF_STEP(PX0, PX1, mnX, alX, PY0, PY1, alY, t, KB, VB, SB) do {                                                      \
        SBAR(); qkt<KB>(PX0, PX1, K_lds, r32, hi, S.qr);                                             \
        finishSM(PY0, PY1, alY, l_reg, pa0, pa1, pa2, pa3); SBAR();                                                           \
        if ((t) + 1 < NT) { SLOAD_H(Kh, Vh, KBASE((t) + 1)); SBAR(); }                                               \
        pv_tile<VB>(o, vb0, pa0, pa1, pa2, pa3); MASKT(PX0, PX1, (t)); partialSM(PX0, PX1, m_reg, mnX, alX);                                        \
        __syncthreads();                                                                                                      \
        if ((t) + 1 < NT) { VMW(); SWRITE_H(SB); }                                                                          \
        RESC(alX); __syncthreads(); } while (0)
    for (int t = 1; t + 1 < NT; t += 2) {
        HALF_STEP(pB0, pB1, mnB, alB, pA0, pA1, alA, t, 1, 0, 0);
        HALF_STEP(pA0, pA1, mnA, alA, pB0, pB1, alB, t + 1, 0, 1, 1);
    }
    const bool even = (NT & 1) == 0;
    if (even) { SBAR(); qkt<1>(pB0, pB1, K_lds, r32, hi, S.qr); SBAR(); }
    { SLOAD_H(nxt.K, nxt.V, kbn); SBAR();
#pragma unroll
        for (int d0 = 0; d0 < 8; ++d0) S.qr[d0] = load8(nxt.Q + (size_t)(wid * QBLK + r32) * PITCH + d0 * 16 + hi * 8); }
    SBAR();
    finishSM(pA0, pA1, alA, l_reg, pa0, pa1, pa2, pa3); SBAR();
    pv_tile<0>(o, vb0, pa0, pa1, pa2, pa3);
    if (even) { MASKT(pB0, pB1, NT - 1); partialSM(pB0, pB1, m_reg, mnB, alB); __syncthreads(); RESC(alB);
        finishSM(pB0, pB1, alB, l_reg, pa0, pa1, pa2, pa3); SBAR(); pv_tile<1>(o, vb0, pa0, pa1, pa2, pa3); }
    SBAR(); SEAM_K0();
    if (hi == 0) li_l[r32] = l_reg; asm volatile("s_waitcnt lgkmcnt(0)" ::: "memory");
    float rli[16];
#pragma unroll
    for (int r = 0; r < 16; ++r) rli[r] = __builtin_amdgcn_rcpf(li_l[crow(r, hi)]);
    GAS bf16_t* Ow = cur.O + (size_t)(wid * QBLK) * PITCH;
#pragma unroll
    for (int r = 0; r < 16; ++r) { const int orow = crow(r, hi);
#pragma unroll
        for (int d0 = 0; d0 < 4; ++d0) { const float v = o[d0][r] * rli[r];
            const float vn = __shfl_xor(v, 1);
            if ((r32 & 1) == 0) *(GAS unsigned*)(Ow + (size_t)orow * PITCH + d0 * 32 + r32) = cvtpk(v, vn); } }
    __syncthreads();
#undef RESC
#undef KBASE
#undef MASKT
#undef SEAM_K0
#undef HALF_STEP
}

constexpr int A3_V = 0, A3_K = 4 * SHM_V, A3_WS = 4 * SHM_V + 4 * SHM_K + 1024, A3_KMEAN = A3_WS + 2048;
struct Seam3 { bf16x8 qr[8]; bf16x8 v00, v01, v10, v11; };
__device__ __forceinline__ void attn_block3(const GAS bf16_t* Kh, const GAS bf16_t* Vh, GAS bf16_t* Ow, const int P0, const int qlo, const int NS, char* lds, Seam3& S, unsigned selmask, const int tid) {
    const int W = WBIG;
    const int wid = __builtin_amdgcn_readfirstlane(tid >> 6), lane = tid & 63, r32 = lane & 31, hi = lane >> 5, g = wid >> 2;
    const int qm = qlo + r32 - 4 * hi;
    char* V_lds = lds + A3_V + g * SHM_V; char* K_lds = lds + A3_K + g * SHM_K;
    float* ws = (float*)(lds + A3_WS) + wid * 64; float* li_l = ws, * al_l = ws + 32;
    float m_reg = -1e30f, l_reg = 0; f32x16 o[4] = {};
    const int sr = tid >> 4, sc = (tid & 15) * 8, vst0 = v_st(sr, sc), vst1 = v_st(32 + sr, sc);
    const int vb0 = (int)(uintptr_t)V_lds + v_rd_base(lane);
    const unsigned voff = (unsigned)(sr * PITCH + sc) * 2u;
    unsigned koff[2];
#pragma unroll
    for (int i = 0; i < 2; ++i) { const int row = 4 * (2 * wid + i) + (lane >> 4), p = lane & 15; koff[i] = (unsigned)(row * PITCH + ((p ^ (row & 7)) << 3)) * 2u; }
#define KDMA3(step, buf) do { _Pragma("unroll") for (int gq_ = 0; gq_ < 2; ++gq_) { const GAS char* kt_ = (const GAS char*)Kh + (size_t)((2 * (step) + gq_) * KVBLK) * (PITCH * 2); \
        _Pragma("unroll") for (int i_ = 0; i_ < 2; ++i_) __builtin_amdgcn_global_load_lds((const unsigned*)(kt_ + koff[i_]), (LAS unsigned*)((LAS char*)lds + A3_K + ((buf) * 2 + gq_) * SHM_K + (2 * wid + i_) * 1024), 16, 0, 0); } } while (0)
#define VLOAD3(step) do { const GAS char* v0_ = (const GAS char*)Vh + (size_t)((2 * (step)) * KVBLK) * (PITCH * 2); const GAS char* v1_ = v0_ + (size_t)KVBLK * (PITCH * 2); \
        S.v00 = *(const GAS bf16x8*)(v0_ + voff); S.v01 = *(const GAS bf16x8*)(v0_ + voff + 32 * PITCH * 2); S.v10 = *(const GAS bf16x8*)(v1_ + voff); S.v11 = *(const GAS bf16x8*)(v1_ + voff + 32 * PITCH * 2); } while (0)
#define VWRITE3(buf) do { char* vb_ = lds + A3_V + (buf) * 2 * SHM_V; *(bf16x8*)(vb_ + vst0) = S.v00; *(bf16x8*)(vb_ + vst1) = S.v01; *(bf16x8*)(vb_ + SHM_V + vst0) = S.v10; *(bf16x8*)(vb_ + SHM_V + vst1) = S.v11; } while (0)
#define RESC(a) do { if (__any((a) < 1.f)) { if (hi == 0) al_l[r32] = (a); asm volatile("s_waitcnt lgkmcnt(0)" ::: "memory");              \
                     for (int d_ = 0; d_ < 4; ++d_) for (int r = 0; r < 16; ++r) o[d_][r] *= al_l[crow(r, hi)]; } } while (0)
#define KBASE(t) ((2 * (t) + g) * KVBLK)
#define MASKT(P0_, P1_, t) do { const int kb_ = KBASE(t); if (kb_ + KVBLK - 1 > qlo) mask_tile(P0_, P1_, qm - kb_, (unsigned)W); \
        if (kb_ < P0) { const bool keep_ = ((selmask >> (kb_ >> 8)) & 1u) != 0u; const float NEG_ = -__builtin_inff(); \
            _Pragma("unroll") for (int r_ = 0; r_ < 16; ++r_) { P0_[r_] = keep_ ? P0_[r_] : NEG_; P1_[r_] = keep_ ? P1_[r_] : NEG_; } } } while (0)
    f32x16 pA0, pA1, pB0, pB1; float mnA, mnB, alA = 1.f, alB = 1.f; bf16x8 pa0, pa1, pa2, pa3;
    VWRITE3(0); SBAR();
    if (NS > 1) { KDMA3(1, 1); VLOAD3(1); }
    SBAR(); qkt<0>(pA0, pA1, K_lds, r32, hi, S.qr);
    MASKT(pA0, pA1, 0); partialSM(pA0, pA1, m_reg, mnA, alA);
    VMW(); LDS_WAIT(); __syncthreads();
#define HALF_STEP3(PX0, PX1, mnX, alX, PY0, PY1, alY, t, KB, VB, SB) do {                                                     \
        SBAR(); VWRITE3(KB);                                                                                                  \
        if ((t) + 1 < NS) { KDMA3((t) + 1, SB); VLOAD3((t) + 1); } SBAR();             \
        qkt<2 * KB>(PX0, PX1, K_lds, r32, hi, S.qr);                                                                          \
        finishSM(PY0, PY1, alY, l_reg, pa0, pa1, pa2, pa3); SBAR();                                                           \
        pv_tile<2 * VB>(o, vb0, pa0, pa1, pa2, pa3); MASKT(PX0, PX1, (t)); partialSM(PX0, PX1, m_reg, mnX, alX);              \
        RESC(alX);                                                                                                            \
        VMW(); LDS_WAIT(); __syncthreads(); } while (0)
    for (int t = 1; t + 1 < NS; t += 2) {
        HALF_STEP3(pB0, pB1, mnB, alB, pA0, pA1, alA, t, 1, 0, 0);
        HALF_STEP3(pA0, pA1, mnA, alA, pB0, pB1, alB, t + 1, 0, 1, 1);
    }
    const bool even = (NS & 1) == 0;
    if (even) { SBAR(); VWRITE3(1); SBAR(); qkt<2>(pB0, pB1, K_lds, r32, hi, S.qr); SBAR(); }
    finishSM(pA0, pA1, alA, l_reg, pa0, pa1, pa2, pa3); SBAR();
    pv_tile<0>(o, vb0, pa0, pa1, pa2, pa3);
    if (even) { MASKT(pB0, pB1, NS - 1); partialSM(pB0, pB1, m_reg, mnB, alB); RESC(alB);
        LDS_WAIT(); __syncthreads();
        finishSM(pB0, pB1, alB, l_reg, pa0, pa1, pa2, pa3); SBAR(); pv_tile<2>(o, vb0, pa0, pa1, pa2, pa3); }
    __syncthreads();
    constexpr float C2 = 1.4426950408889634f * SCALE;
    float* ob = (float*)(lds + A3_V) + (wid & 3) * 4096;
    if (g == 1) { if (hi == 0) { li_l[r32] = m_reg; al_l[r32] = l_reg; }
#pragma unroll
        for (int d0 = 0; d0 < 4; ++d0)
#pragma unroll
            for (int r = 0; r < 16; ++r) ob[(d0 * 16 + r) * 64 + lane] = o[d0][r]; }
    asm volatile("s_waitcnt lgkmcnt(0)" ::: "memory");
    __syncthreads();
    if (g == 0) { const float* pw = (const float*)(lds + A3_WS) + (wid + 4) * 64;
        const float mB = pw[r32], lB = pw[32 + r32];
        const float m = fmaxf(m_reg, mB), fa = __builtin_amdgcn_exp2f((m_reg - m) * C2), fb = __builtin_amdgcn_exp2f((mB - m) * C2);
        const float inv = __builtin_amdgcn_rcpf(l_reg * fa + lB * fb);
        if (hi == 0) { li_l[r32] = fa * inv; al_l[r32] = fb * inv; }
        asm volatile("s_waitcnt lgkmcnt(0)" ::: "memory");
        LAS unsigned short* tile = (LAS unsigned short*)((LAS char*)lds + A3_K + (wid & 3) * 8704);
#pragma unroll
        for (int r = 0; r < 16; ++r) { const int orow = crow(r, hi); const float wa = li_l[orow], wb = al_l[orow];
#pragma unroll
            for (int d0 = 0; d0 < 4; ++d0) { const float v = o[d0][r] * wa + ob[(d0 * 16 + r) * 64 + lane] * wb;
                tile[orow * 136 + d0 * 32 + r32] = (unsigned short)(cvtpk(v, 0.f) & 0xffffu); } } }
    asm volatile("s_waitcnt lgkmcnt(0)" ::: "memory");
    __syncthreads();
    { const LAS char* tl = (const LAS char*)lds + A3_K + (wid & 3) * 8704;
#pragma unroll
      for (int i = 0; i < 4; ++i) { const int q = lane + 64 * (2 * i + g), row = q >> 4, c16 = q & 15;
          const u32x4 w = *(const LAS u32x4*)(tl + row * 272 + c16 * 16);
          *(GAS u32x4*)(Ow + (size_t)row * PITCH + c16 * 8) = w; } }
    __syncthreads();
#undef RESC
#undef KBASE
#undef MASKT
#undef HALF_STEP3
#undef KDMA3
#undef VLOAD3
#undef VWRITE3
}
#undef ROW
#undef VMWN
#undef SLOAD_H
#undef SWRITE_HK
#undef SWRITE_HV
#undef SWRITE_H

__device__ __forceinline__ void attn_unit(int b, int h, int qb, const GAS bf16_t* Q, const GAS bf16_t* K, const GAS bf16_t* V, GAS bf16_t* O, const GAS float* ksum, char* lds, const int tid) {
    const int lane = tid & 63, hi = lane >> 5;
    const size_t hb = (size_t)b * SEQ * PITCH + (size_t)h * D;
    BlockRef cur; cur.Q = Q + hb + (size_t)qb * QB * PITCH; cur.K = K + hb; cur.V = V + hb; cur.O = O + hb + (size_t)qb * QB * PITCH; cur.P0 = qb * QB;
    Seam S;
    attn_prime(cur, lds, S, tid);
    float* kmean = (float*)(lds + KMEAN_OFF);
    { for (int i = tid; i < qb * 128; i += 512) { const int j = i >> 7, d = i & 127; const GAS float* kp = ksum + ((size_t)(b * 8 + j) * 2) * 1024 + h * D + d;
          kmean[i] = (kp[0] + kp[1024]) * (1.0f / 256.0f); }
      __syncthreads(); }
    unsigned selmask = 0u;
    { float gate[7];
#pragma unroll
      for (int j = 0; j < 7; ++j) {
          if (j < qb) { float s = 0.f;
#pragma unroll
              for (int d0 = 0; d0 < 8; ++d0) { const float* km = kmean + j * 128 + d0 * 16 + hi * 8;
#pragma unroll
                  for (int i = 0; i < 8; ++i) s += bf2f((unsigned short)S.qr[d0][i]) * km[i]; }
              s += __shfl_xor(s, 32); gate[j] = s; }
          else gate[j] = -__builtin_inff(); }
#pragma unroll
      for (int k = 0; k < 3; ++k) { float best = -__builtin_inff(); int bi = -1;
#pragma unroll
          for (int j = 0; j < 7; ++j) { const bool cand = ((selmask >> j) & 1u) == 0u && gate[j] > best; if (cand) { best = gate[j]; bi = j; } }
          if (bi >= 0) selmask |= 1u << bi; } }
    attn_block(cur, cur, lds, S, selmask, tid);
}
__device__ __forceinline__ void attn_unit3(int b, int h, int qb, int half, const GAS bf16_t* Q, const GAS bf16_t* K, const GAS bf16_t* V, GAS bf16_t* O, const GAS float* ksum, char* lds, const int tid) {
    const int lane = tid & 63, r32 = lane & 31, hi = lane >> 5, wid = __builtin_amdgcn_readfirstlane(tid >> 6);
    const size_t hb = (size_t)b * SEQ * PITCH + (size_t)h * D;
    const int qrow = qb * QB + half * 128 + (wid & 3) * QBLK, NS = 2 * qb + half + 1;
    Seam3 S;
    { const GAS bf16_t* Qw = Q + hb + (size_t)qrow * PITCH;
      for (int d0 = 0; d0 < 8; ++d0) S.qr[d0] = load8(Qw + (size_t)r32 * PITCH + d0 * 16 + hi * 8);
      const int sr = tid >> 4, sc = (tid & 15) * 8; const unsigned voff = (unsigned)(sr * PITCH + sc) * 2u;
#pragma unroll
      for (int gq = 0; gq < 2; ++gq)
#pragma unroll
          for (int i = 0; i < 2; ++i) { const int row = 4 * (2 * wid + i) + (lane >> 4), p = lane & 15;
              __builtin_amdgcn_global_load_lds((const unsigned*)((const GAS char*)(K + hb) + (size_t)(gq * KVBLK) * (PITCH * 2) + (unsigned)(row * PITCH + ((p ^ (row & 7)) << 3)) * 2u),
                                               (LAS unsigned*)((LAS char*)lds + A3_K + gq * SHM_K + (2 * wid + i) * 1024), 16, 0, 0); }
      const GAS char* v0 = (const GAS char*)(V + hb); const GAS char* v1 = v0 + (size_t)KVBLK * (PITCH * 2);
      S.v00 = *(const GAS bf16x8*)(v0 + voff); S.v01 = *(const GAS bf16x8*)(v0 + voff + 32 * PITCH * 2); S.v10 = *(const GAS bf16x8*)(v1 + voff); S.v11 = *(const GAS bf16x8*)(v1 + voff + 32 * PITCH * 2); }
    float* kmean = (float*)(lds + A3_KMEAN);
    { for (int i = tid; i < qb * 128; i += 512) { const int j = i >> 7, d = i & 127; const GAS float* kp = ksum + ((size_t)(b * 8 + j) * 2) * 1024 + h * D + d;
          kmean[i] = (kp[0] + kp[1024]) * (1.0f / 256.0f); }
      VMW(); __syncthreads(); }
    unsigned selmask = 0u;
    { float gate[7];
#pragma unroll
      for (int j = 0; j < 7; ++j) {
          if (j < qb) { float s = 0.f;
#pragma unroll
              for (int d0 = 0; d0 < 8; ++d0) { const float* km = kmean + j * 128 + d0 * 16 + hi * 8;
#pragma unroll
                  for (int i = 0; i < 8; ++i) s += bf2f((unsigned short)S.qr[d0][i]) * km[i]; }
              s += __shfl_xor(s, 32); gate[j] = s; }
          else gate[j] = -__builtin_inff(); }
#pragma unroll
      for (int k = 0; k < 3; ++k) { float best = -__builtin_inff(); int bi = -1;
#pragma unroll
          for (int j = 0; j < 7; ++j) { const bool cand = ((selmask >> j) & 1u) == 0u && gate[j] > best; if (cand) { best = gate[j]; bi = j; } }
          if (bi >= 0) selmask |= 1u << bi; } }
    int tb = tid; asm volatile("" : "+v"(tb));
    attn_block3(K + hb, V + hb, O + hb + (size_t)qrow * PITCH, qb * QB, qrow, NS, lds, S, selmask, tb);
}
#undef VMW
}

#define XB_TMO      128
#define XB_XCNT(j)  (256  + 64 * (j))
#define XB_XSUB(j)  (1280 + 64 * (j))
#define XB_XGEN(j)  (2304 + 64 * (j))
#define XB_TOP      3328
#define XB_TOPGEN   3392
#define XCD_BAR_WORDS 3456
#define XB_SPIN_CAP (1u << 18)
__device__ __forceinline__ unsigned xb_ld(unsigned* p)              { return __hip_atomic_load(p, __ATOMIC_RELAXED, __HIP_MEMORY_SCOPE_AGENT); }
__device__ __forceinline__ unsigned xb_add(unsigned* p, unsigned v) { return __hip_atomic_fetch_add(p, v, __ATOMIC_RELAXED, __HIP_MEMORY_SCOPE_AGENT); }
__device__ __forceinline__ unsigned xb_xcc_id() { return (unsigned)__builtin_amdgcn_s_getreg((3 << 11) | 20) & 0xFu; }
#define XB_SPIN(cond, bar) do { unsigned _sp = 0; while (cond) { __builtin_amdgcn_s_sleep(1); \
    if ((++_sp & 255u) == 0u) { if (xb_ld(&(bar)[XB_TMO])) break; if (_sp > XB_SPIN_CAP) { atomicAdd(&(bar)[XB_TMO], 1u); break; } } } } while (0)
struct XcdBarrier { unsigned* bar; unsigned x; volatile LAS unsigned* st; };
__device__ __forceinline__ XcdBarrier xcd_barrier_post(unsigned* bar, volatile LAS unsigned* st) {
    XcdBarrier b; b.bar = bar; b.x = xb_xcc_id(); b.st = st;
    if (threadIdx.x == 0) (void)xb_add(&bar[XB_XCNT(b.x)], 1u);
    return b;
}
__device__ __forceinline__ void xcd_barrier_complete(unsigned* bar, unsigned x, unsigned& nloc, unsigned& nx) {
    const unsigned G = gridDim.x * gridDim.y * gridDim.z;
    unsigned sum, cnt, mine, sp = 0u;
    for (;;) {
        sum = 0u; cnt = 0u; mine = 0u;
#pragma unroll
        for (unsigned j = 0; j < 16; ++j) { const unsigned c = xb_ld(&bar[XB_XCNT(j)]); sum += c; cnt += (c > 0u) ? 1u : 0u; mine = (j == x) ? c : mine; }
        if (sum == G) break;
        __builtin_amdgcn_s_sleep(1);
        if ((++sp & 255u) == 0u) { if (xb_ld(&bar[XB_TMO])) break; if (sp > XB_SPIN_CAP) { atomicAdd(&bar[XB_TMO], 1u); break; } }
    }
    nloc = mine > 0u ? mine : 1u; nx = cnt > 0u ? cnt : 1u;
}
__device__ __forceinline__ void xcd_barrier(const XcdBarrier& b, const bool first_thread) {
    asm volatile("s_waitcnt vmcnt(0)" ::: "memory");
    __syncthreads();
    if (first_thread) {
        unsigned* bar = b.bar;
        __builtin_amdgcn_s_waitcnt(0);
        unsigned nloc = b.st[0], nx = b.st[1];
        if (nloc == 0u) { xcd_barrier_complete(bar, b.x, nloc, nx); b.st[0] = nloc; b.st[1] = nx; }
        const unsigned old = xb_add(&bar[XB_XSUB(b.x)], 1u);
        const unsigned gen = old / nloc;
        if (old + 1u == (gen + 1u) * nloc) {
            __builtin_amdgcn_fence(__ATOMIC_RELEASE, "agent");
            asm volatile("s_waitcnt vmcnt(0)" ::: "memory");
            const unsigned og = xb_add(&bar[XB_TOP], 1u);
            const unsigned tg = og / nx;
            if (og + 1u == (tg + 1u) * nx) xb_add(&bar[XB_TOPGEN], 1u);
            else XB_SPIN(xb_ld(&bar[XB_TOPGEN]) == tg, bar);
            __builtin_amdgcn_fence(__ATOMIC_ACQUIRE, "agent");
            xb_add(&bar[XB_XGEN(b.x)], 1u);
            asm volatile("s_waitcnt vmcnt(0)" ::: "memory");
        } else {
            XB_SPIN(xb_ld(&bar[XB_XGEN(b.x)]) == gen, bar);
            __builtin_amdgcn_fence(__ATOMIC_ACQUIRE, "agent");
            asm volatile("s_waitcnt vmcnt(0)" ::: "memory");
        }
    }
    __syncthreads();
}

#ifndef BAR2
#define BAR2 1
#endif
__device__ __forceinline__ void xcd_barrier2(unsigned* bar, const unsigned x, volatile LAS unsigned* st, const int tid) {
    asm volatile("s_waitcnt vmcnt(0)" ::: "memory");
    __syncthreads();
    if (tid < 64) {
        unsigned k = 0u;
        if (tid == 0) {
            __builtin_amdgcn_s_waitcnt(0);
            unsigned nloc = st[0], nx = st[1];
            if (nloc == 0u) { xcd_barrier_complete(bar, x, nloc, nx); st[0] = nloc; st[1] = nx; unsigned mask = 0u;
#pragma unroll
                for (unsigned j = 0; j < 16; ++j) mask |= (xb_ld(&bar[XB_XCNT(j)]) > 0u ? 1u : 0u) << j;
                st[2] = mask; }
            const unsigned old = xb_add(&bar[XB_XSUB(x)], 1u);
            k = old / nloc + 1u;
            if (old + 1u == k * nloc) { __builtin_amdgcn_fence(__ATOMIC_RELEASE, "agent"); asm volatile("s_waitcnt vmcnt(0)" ::: "memory");
                (void)__hip_atomic_fetch_add(&bar[XB_XGEN(x)], 1u, __ATOMIC_RELAXED, __HIP_MEMORY_SCOPE_AGENT); }
        }
        k = (unsigned)__builtin_amdgcn_readfirstlane((int)k);
        asm volatile("s_waitcnt lgkmcnt(0)" ::: "memory");
        const unsigned mask = st[2]; const bool part = ((mask >> (tid & 15)) & 1u) != 0u;
        unsigned* p = &bar[XB_XGEN(tid & 15)];
        for (unsigned sp = 0; sp < XB_SPIN_CAP; ++sp) { unsigned v = k; if (tid < 16 && part) v = xb_ld(p);
            if (__all(v >= k)) break; __builtin_amdgcn_s_sleep(1); }
        __builtin_amdgcn_fence(__ATOMIC_ACQUIRE, "agent");
        asm volatile("s_waitcnt vmcnt(0) lgkmcnt(0)" ::: "memory");
    }
    __syncthreads();
}

struct CvItem { const GAS float* W; GAS bf16_t* WT; const GAS float* gain; int K, N, k0, n0, drow0; };
constexpr int CV_P = 16 * 32, CV_O = 32 * 32, CV_F = 2816, CV_MIX = 2 * CV_P + CV_O;
constexpr int CV_END_MIX0 = CV_MIX, CV_END_DDOWN = CV_MIX + 0 * CV_F, CV_END_MIX1 = CV_END_DDOWN + CV_MIX, CV_TOTAL = CV_END_MIX1;
constexpr int CV_END_WIN0 = 0, CV_END_WPB0 = 0, CV_END_WO0 = 0, CV_END_DUP = 0, CV_END_WIN1 = 0, CV_END_WPB1 = 0, CV_END_WO1 = 0, CV_END_EGU = 0;
__device__ __forceinline__ void cv_set(CvItem& d, const GAS float* W, int K, int N, GAS bf16_t* WT, const GAS float* gain, int mode, int r) {
    const int nblk = N / 64, kb = r / nblk, nb = r - kb * nblk; d.W = W; d.WT = WT; d.gain = gain; d.K = K; d.N = N; d.k0 = 64 * kb; d.n0 = 64 * nb;
    const int n0 = d.n0; d.drow0 = mode == 0 ? n0 : (256 * (n0 >> 7) + (n0 & 127) + (mode == 2 ? 128 : 0));
}
__device__ __forceinline__ void cv_mixer(CvItem& d, const float* const* in, GAS unsigned char* ws, int l, int r) {
    if (r < CV_P) { cv_set(d, (const GAS float*)in[6] + (size_t)l * AW * DM, AW, DM, (GAS bf16_t*)(ws + WS_WPA) + (size_t)l * 2 * DM * AW, nullptr, 0, r); return; } r -= CV_P;
    if (r < CV_P) { cv_set(d, (const GAS float*)in[7] + (size_t)l * SW * DM, SW, DM, (GAS bf16_t*)(ws + WS_WPA) + (size_t)l * 2 * DM * AW + (size_t)DM * AW, nullptr, 0, r); return; } r -= CV_P;
    cv_set(d, (const GAS float*)in[8] + (size_t)l * DM * DM, DM, DM, (GAS bf16_t*)(ws + WS_WO) + (size_t)l * DM * DM, nullptr, 0, r);
}
__device__ __forceinline__ void cv_decode(CvItem& d, const float* const* in, GAS unsigned char* ws, int g) {
    if (g < CV_END_MIX0) { cv_mixer(d, in, ws, 0, g); return; }
    if (g < CV_END_DDOWN) { cv_set(d, (const GAS float*)in[12], FF, DM, (GAS bf16_t*)(ws + WS_WD), nullptr, 0, g - CV_END_MIX0); return; }
    cv_mixer(d, in, ws, 1, g - CV_END_DDOWN);
}
__device__ __forceinline__ void cv_load(const CvItem& d, int lane, f32x4 (&v)[16], float (&gv)[16]) {
    const int r = lane >> 4, c4 = lane & 15;
#pragma unroll
    for (int i = 0; i < 8; ++i)
#pragma unroll
        for (int p = 0; p < 2; ++p) { const int k = d.k0 + 8 * i + 2 * r + p; v[2 * i + p] = __builtin_nontemporal_load((const GAS f32x4*)(d.W + (size_t)k * d.N + d.n0 + 4 * c4)); gv[2 * i + p] = d.gain ? d.gain[k] : 1.0f; }
}
__device__ __forceinline__ void cv_finish(const CvItem& d, int lane, const f32x4 (&v)[16], const float (&gv)[16], LAS unsigned* scr) {
    const int r = lane >> 4, c4 = lane & 15;
#pragma unroll
    for (int i = 0; i < 8; ++i) { const f32x4 a = v[2 * i] * gv[2 * i], b = v[2 * i + 1] * gv[2 * i + 1];
#pragma unroll
        for (int j = 0; j < 4; ++j) scr[(4 * c4 + j) * 36 + 4 * i + r] = cvt_pk_bf16(a[j], b[j]); }
    LDS_WAIT(); asm volatile("" ::: "memory");
    const int rn = lane >> 3, c = lane & 7;
#pragma unroll
    for (int m = 0; m < 8; ++m) { const int n = rn + 8 * m; const u32x4 o = *(const LAS u32x4*)(scr + n * 36 + 4 * c);
        __builtin_nontemporal_store(o, (GAS u32x4*)(d.WT + (size_t)(d.drow0 + n) * d.K + d.k0 + 8 * c)); }
    LDS_WAIT(); asm volatile("" ::: "memory");
}
template <bool LOOK> __device__ __forceinline__ void bg_convert(const float* const* in, GAS unsigned char* ws, unsigned* ctl, LAS unsigned char* lds, volatile LAS unsigned* flagw, int lane, int wave, int bx, int G, int must, int phase, int nlook) {
    const int q = bx & 7; unsigned* head = ctl + CW_QH + 64 * q; unsigned* done = ctl + CW_DONE + 64 * phase;
    LAS unsigned* scr = (LAS unsigned*)(lds + wave * 16384);
    const bool look = LOOK && wave != 0 && wave <= nlook;
    const unsigned fl = (unsigned)phase + 1u;
    bool skip = false;
    { const int g0 = (int)__builtin_amdgcn_readfirstlane(__hip_atomic_load(head, __ATOMIC_RELAXED, __HIP_MEMORY_SCOPE_AGENT)) * 8 + q;
      if (g0 >= CV_TOTAL) skip = true;
      else if (g0 >= must) { if (!LOOK) skip = true; else if ((int)__builtin_amdgcn_readfirstlane(__hip_atomic_load(done, __ATOMIC_RELAXED, __HIP_MEMORY_SCOPE_AGENT)) >= G) skip = true; else skip = !look; } }
    if (!skip) {
#define CV_PULL(dst, lastg) do { bool more_ = (lastg) + 8 < must; if (look && !more_) more_ = flagw[0] != fl; \
        dst = 0x0fffffffu; if (more_ && lane == 0) dst = __hip_atomic_fetch_add(head, 1u, __ATOMIC_RELAXED, __HIP_MEMORY_SCOPE_AGENT); } while (0)
        unsigned pulled = 0u; if (lane == 0) pulled = __hip_atomic_fetch_add(head, 1u, __ATOMIC_RELAXED, __HIP_MEMORY_SCOPE_AGENT);
        int gA = (int)__builtin_amdgcn_readfirstlane(pulled) * 8 + q;
        if (gA < CV_TOTAL) {
            CvItem dA, dB; f32x4 vA[16], vB[16]; float gvA[16], gvB[16];
            cv_decode(dA, in, ws, gA); cv_load(dA, lane, vA, gvA);
            unsigned pb_; CV_PULL(pb_, gA);
            int gB = (int)__builtin_amdgcn_readfirstlane(pb_) * 8 + q;
            for (;;) {
                unsigned pc_ = 0x0fffffffu;
                if (gB < CV_TOTAL) { CV_PULL(pc_, gB); cv_decode(dB, in, ws, gB); cv_load(dB, lane, vB, gvB); }
                cv_finish(dA, lane, vA, gvA, scr);
                if (gB >= CV_TOTAL) break;
                dA = dB; gA = gB;
#pragma unroll
                for (int i = 0; i < 16; ++i) { vA[i] = vB[i]; gvA[i] = gvB[i]; }
                gB = (int)__builtin_amdgcn_readfirstlane(pc_) * 8 + q;
            }
        }
#undef CV_PULL
    }
    if (LOOK && wave == 0) {
        for (unsigned sp = 0; sp < (1u << 22); ++sp) {
            if ((int)__builtin_amdgcn_readfirstlane(__hip_atomic_load(done, __ATOMIC_RELAXED, __HIP_MEMORY_SCOPE_AGENT)) >= G) break;
            if ((int)__builtin_amdgcn_readfirstlane(__hip_atomic_load(head, __ATOMIC_RELAXED, __HIP_MEMORY_SCOPE_AGENT)) * 8 + q >= CV_TOTAL) break;
            __builtin_amdgcn_s_sleep(8); }
        if (lane == 0) flagw[0] = fl;
    }
}
__device__ __forceinline__ void rms_row(const GAS float* xrow, int lane, f32x4 (&v)[8]) {
    const GAS f32x4* xr = (const GAS f32x4*)xrow + lane; float s = 0.f;
#pragma unroll
    for (int j = 0; j < 8; ++j) { v[j] = xr[64 * j]; s += (v[j].x * v[j].x + v[j].y * v[j].y) + (v[j].z * v[j].z + v[j].w * v[j].w); }
    const float rstd = 1.0f / sqrtf(wave_sum(s) * (1.0f / DM) + EPS);
#pragma unroll
    for (int j = 0; j < 8; ++j) v[j] = v[j] * rstd;
}
__device__ __forceinline__ void rms_row_bf(const GAS bf16_t* xrow, int lane, f32x4 (&v)[8]) {
    const GAS u32x2* xr = (const GAS u32x2*)xrow + lane; float s = 0.f;
#pragma unroll
    for (int j = 0; j < 8; ++j) { const u32x2 w = xr[64 * j]; v[j] = (f32x4){bflo(w.x), bfhi(w.x), bflo(w.y), bfhi(w.y)}; s += (v[j].x * v[j].x + v[j].y * v[j].y) + (v[j].z * v[j].z + v[j].w * v[j].w); }
    const float rstd = 1.0f / sqrtf(wave_sum(s) * (1.0f / DM) + EPS);
#pragma unroll
    for (int j = 0; j < 8; ++j) v[j] = v[j] * rstd;
}
__device__ __forceinline__ void store_row_bf16(GAS bf16_t* orow, int lane, const f32x4 (&v)[8]) {
    GAS u32x2* o8 = (GAS u32x2*)orow + lane;
#pragma unroll
    for (int j = 0; j < 8; ++j) { u32x2 w; w.x = cvt_pk_bf16(v[j].x, v[j].y); w.y = cvt_pk_bf16(v[j].z, v[j].w); o8[64 * j] = w; }
}

__device__ __forceinline__ void store_row_i8(GAS unsigned* row8, GAS float* sc, int lane, const f32x4 (&v)[8]) {
    float am = 0.f;
#pragma unroll
    for (int j = 0; j < 8; ++j) am = fmaxf(am, fmaxf(fmaxf(fabsf(v[j].x), fabsf(v[j].y)), fmaxf(fabsf(v[j].z), fabsf(v[j].w))));
    am = wave_max(am); const float inv = am > 0.f ? 127.0f / am : 0.f;
#pragma unroll
    for (int j = 0; j < 8; ++j) row8[64 * j + lane] = pack_i8x4(v[j], inv);
    if (lane == 0) *sc = am > 0.f ? am * (1.0f / 127.0f) : 1.0f;
}
constexpr int Q8_FF_STRIPS = FF / 32, Q8_IN_STRIPS = INW / 32, Q8_STRIPS = 18 * Q8_FF_STRIPS + 2 * Q8_IN_STRIPS;
constexpr int Q8_CMAX_OFF = RING_BYTES + 8192;
__device__ __forceinline__ void q8_strip(const float* const* in, GAS unsigned char* ws, LAS unsigned char* lds, int s, int tid) {
    const int lane = tid & 63, wid = __builtin_amdgcn_readfirstlane(tid >> 6);
    const GAS float* W; const GAS float* gain; GAS unsigned char* dst; GAS float* sb = (GAS float*)(ws + WS_SB); int N, n0, drow0;
    if (s < 18 * Q8_FF_STRIPS) { const int mtx = s / Q8_FF_STRIPS, t = s - mtx * Q8_FF_STRIPS; N = FF; n0 = 32 * t;
        const int up = mtx & 1, e = (mtx >> 1) - 1; drow0 = 256 * (n0 >> 7) + (n0 & 127) + (up ? 128 : 0);
        if (mtx < 2) { W = (const GAS float*)in[up ? 11 : 10]; gain = (const GAS float*)in[9]; dst = ws + WS_WGU; }
        else { W = (const GAS float*)in[up ? 16 : 15] + (size_t)e * DM * FF; gain = (const GAS float*)in[9] + DM; dst = ws + WS_WEGU + (size_t)e * (2 * FF) * P8B; sb += 11264 * (1 + e); } }
    else { const int r = s - 18 * Q8_FF_STRIPS, l = r / Q8_IN_STRIPS, t = r - l * Q8_IN_STRIPS; N = INW; n0 = 32 * t; drow0 = n0;
        W = (const GAS float*)in[2] + (size_t)l * DM * INW; gain = (const GAS float*)in[1] + l * DM; dst = ws + WS_WIN + (size_t)l * INW * P8B; sb += SB_WIN + l * INW; }
    LAS unsigned* img = (LAS unsigned*)lds;
    LAS unsigned* cmax = (LAS unsigned*)(lds + Q8_CMAX_OFF);
    if (tid < 32) cmax[tid] = 0u;
    __syncthreads();
    { const int r = lane >> 3, c4 = lane & 7; float mx[4] = {0.f, 0.f, 0.f, 0.f};
#pragma unroll 1
      for (int b = 0; b < 4; ++b) { const int kb = wid * 256 + b * 64; f32x4 v[8]; float gv[8];
#pragma unroll
          for (int i = 0; i < 4; ++i)
#pragma unroll
              for (int p = 0; p < 2; ++p) { const int k = kb + 16 * i + 2 * r + p; v[2 * i + p] = __builtin_nontemporal_load((const GAS f32x4*)(W + (size_t)k * N + n0 + 4 * c4)); gv[2 * i + p] = gain[k]; }
#pragma unroll
          for (int i = 0; i < 4; ++i) { const f32x4 a = v[2 * i] * gv[2 * i], bq = v[2 * i + 1] * gv[2 * i + 1]; const int kd = (kb + 16 * i + 2 * r) >> 1;
#pragma unroll
              for (int j = 0; j < 4; ++j) { const unsigned w = cvt_pk_bf16(a[j], bq[j]); mx[j] = fmaxf(mx[j], fmaxf(fabsf(bflo(w)), fabsf(bfhi(w)))); img[(4 * c4 + j) * 1024 + (kd ^ (c4 << 3))] = w; } } }
#pragma unroll
      for (int j = 0; j < 4; ++j) { float m = mx[j]; m = fmaxf(m, __shfl_xor(m, 8)); m = fmaxf(m, __shfl_xor(m, 16)); m = fmaxf(m, __shfl_xor(m, 32));
          if (r == 0) atomicMax((unsigned*)(cmax + 4 * c4 + j), __float_as_uint(m)); } }
    LDS_WAIT(); __syncthreads();
#pragma unroll
    for (int q = 0; q < 4; ++q) { const int n = wid * 4 + q; const float am = __uint_as_float(cmax[n]); const float inv = am > 0.f ? 127.0f / am : 0.f; const int sw = (n >> 2) << 3;
        GAS unsigned char* rp = dst + (size_t)(drow0 + n) * P8B;
#pragma unroll
        for (int j = 0; j < 4; ++j) { const int d = 4 * (lane + 64 * j); const u32x4 c = *(const LAS u32x4*)(img + n * 1024 + (d ^ sw));
            u32x2 o; o.x = pack_i8x4((f32x4){bflo(c.x), bfhi(c.x), bflo(c.y), bfhi(c.y)}, inv); o.y = pack_i8x4((f32x4){bflo(c.z), bfhi(c.z), bflo(c.w), bfhi(c.w)}, inv);
            __builtin_nontemporal_store(o, (GAS u32x2*)(rp + 8 * (lane + 64 * j))); }
        if (lane == 0) sb[drow0 + n] = am > 0.f ? am * (1.0f / 127.0f) : 1.0f; }
    __syncthreads();
}
#ifndef Q8D_REG
#define Q8D_REG 1
#endif
constexpr int Q8D_STRIPS = Q8D_REG ? 9 * (DM / 16) : 8 * (DM / 32);
__device__ __forceinline__ void q8_strip_down_reg(const float* const* in, GAS unsigned char* ws, LAS unsigned char* lds, int s, int tid) {
    const int e = s >> 7, n0 = 16 * (s & 127), c4 = tid & 3, g = tid >> 2;
    const GAS float* src = (e < 8 ? (const GAS float*)in[17] + (size_t)e * FF * DM : (const GAS float*)in[12]) + (size_t)(44 * g) * DM + n0 + 4 * c4;
    GAS unsigned char* dst = (e < 8 ? ws + WS_WED + (size_t)(e * DM) * (FF * 2) : ws + WS_WD) + (size_t)n0 * (FF * 2); GAS float* sb = (GAS float*)(ws + WS_SB) + (e < 8 ? SB_WED + e * DM : SB_WD) + n0;
    LAS unsigned* cmax = (LAS unsigned*)(lds + Q8_CMAX_OFF); LAS unsigned* img = (LAS unsigned*)lds;
    if (tid < 16) cmax[tid] = 0u;
    unsigned pk[22][4]; float mx[4] = {0.f, 0.f, 0.f, 0.f};
#pragma unroll
    for (int b = 0; b < 11; ++b) { f32x4 v[4];
#pragma unroll
        for (int p = 0; p < 4; ++p) v[p] = __builtin_nontemporal_load((const GAS f32x4*)(src + (size_t)(4 * b + p) * DM));
#pragma unroll
        for (int j = 0; j < 4; ++j) { mx[j] = fmaxf(mx[j], fmaxf(fmaxf(fabsf(v[0][j]), fabsf(v[1][j])), fmaxf(fabsf(v[2][j]), fabsf(v[3][j]))));
            pk[2 * b][j] = cvt_pk_bf16(v[0][j], v[1][j]); pk[2 * b + 1][j] = cvt_pk_bf16(v[2][j], v[3][j]); }
        if (b & 1) asm volatile("" ::: "memory"); }
    __syncthreads();
#pragma unroll
    for (int j = 0; j < 4; ++j) { float m = mx[j]; m = fmaxf(m, __shfl_xor(m, 4)); m = fmaxf(m, __shfl_xor(m, 8)); m = fmaxf(m, __shfl_xor(m, 16)); m = fmaxf(m, __shfl_xor(m, 32));
        if ((tid & 60) == 0) atomicMax((unsigned*)(cmax + 4 * c4 + j), __float_as_uint(m)); }
    LDS_WAIT(); __syncthreads();
    float inv[4];
#pragma unroll
    for (int j = 0; j < 4; ++j) { const float am = bflo(cvt_pk_bf16(__uint_as_float(cmax[4 * c4 + j]), 0.f)); inv[j] = am > 0.f ? 127.0f / am : 0.f; }
#pragma unroll
    for (int d = 0; d < 11; ++d)
#pragma unroll
        for (int j = 0; j < 4; ++j) { const unsigned lo = pk[2 * d][j], hi = pk[2 * d + 1][j];
            img[(4 * c4 + j) * 1412 + 11 * g + d] = pack_i8x4((f32x4){bflo(lo), bfhi(lo), bflo(hi), bfhi(hi)}, inv[j]); }
    LDS_WAIT(); __syncthreads();
#pragma unroll 1
    for (int i = tid; i < 16 * 352; i += 512) { const int n = i / 352, c = i - n * 352; const LAS unsigned* tp = img + n * 1412 + 4 * c;
        u32x4 o; o.x = tp[0]; o.y = tp[1]; o.z = tp[2]; o.w = tp[3];
        *(GAS u32x4*)(dst + (size_t)n * (FF * 2) + 16 * c) = o; }
    if (tid < 16) { const float am = bflo(cvt_pk_bf16(__uint_as_float(cmax[tid]), 0.f)); sb[tid] = am > 0.f ? am * (1.0f / 127.0f) : 1.0f; }
    __syncthreads();
}
__device__ __forceinline__ void q8_strip_down(const float* const* in, GAS unsigned char* ws, LAS unsigned char* lds, int s, int tid) {
    const int lane = tid & 63, wid = __builtin_amdgcn_readfirstlane(tid >> 6);
    const int e = s / (DM / 32), t = s - e * (DM / 32), n0 = 32 * t;
    const GAS float* W = (const GAS float*)in[17] + (size_t)e * FF * DM; GAS unsigned char* dst = ws + WS_WED + (size_t)(e * DM + n0) * (FF * 2); GAS float* sb = (GAS float*)(ws + WS_SB) + SB_WED + e * DM + n0;
    LAS unsigned* cmax = (LAS unsigned*)(lds + Q8_CMAX_OFF); LAS unsigned* tile = (LAS unsigned*)(lds + wid * 4096);
    if (tid < 32) cmax[tid] = 0u;
    __syncthreads();
    const int r = lane >> 3, c4 = lane & 7;
    { float mx[4] = {0.f, 0.f, 0.f, 0.f};
#pragma unroll 1
      for (int b = 0; b < 11; ++b) { const int kb = wid * 704 + b * 64; f32x4 v[8];
#pragma unroll
          for (int i = 0; i < 2; ++i)
#pragma unroll
              for (int p = 0; p < 4; ++p) v[4 * i + p] = *(const GAS f32x4*)(W + (size_t)(kb + 32 * i + 4 * r + p) * DM + n0 + 4 * c4);
#pragma unroll
          for (int q = 0; q < 8; ++q)
#pragma unroll
              for (int j = 0; j < 4; ++j) mx[j] = fmaxf(mx[j], fabsf(v[q][j])); }
#pragma unroll
      for (int j = 0; j < 4; ++j) { float m = mx[j]; m = fmaxf(m, __shfl_xor(m, 8)); m = fmaxf(m, __shfl_xor(m, 16)); m = fmaxf(m, __shfl_xor(m, 32));
          if (r == 0) atomicMax((unsigned*)(cmax + 4 * c4 + j), __float_as_uint(m)); } }
    LDS_WAIT(); __syncthreads();
    { float inv[4];
#pragma unroll
      for (int j = 0; j < 4; ++j) { const float am = __uint_as_float(cmax[4 * c4 + j]); inv[j] = am > 0.f ? 127.0f / am : 0.f; }
#pragma unroll 1
      for (int b = 0; b < 11; ++b) { const int kb = wid * 704 + b * 64; f32x4 v[8];
#pragma unroll
          for (int i = 0; i < 2; ++i)
#pragma unroll
              for (int p = 0; p < 4; ++p) v[4 * i + p] = *(const GAS f32x4*)(W + (size_t)(kb + 32 * i + 4 * r + p) * DM + n0 + 4 * c4);
#pragma unroll
          for (int i = 0; i < 2; ++i)
#pragma unroll
              for (int j = 0; j < 4; ++j) tile[(4 * c4 + j) * 17 + 8 * i + r] = pack_i8x4((f32x4){v[4 * i][j], v[4 * i + 1][j], v[4 * i + 2][j], v[4 * i + 3][j]}, inv[j]);
          LDS_WAIT(); asm volatile("" ::: "memory");
#pragma unroll
          for (int m = 0; m < 2; ++m) { const int n = (lane >> 2) + 16 * m, c = lane & 3; const LAS unsigned* tp = tile + n * 17 + 4 * c;
              u32x4 o; o.x = tp[0]; o.y = tp[1]; o.z = tp[2]; o.w = tp[3];
              *(GAS u32x4*)(dst + (size_t)n * (FF * 2) + kb + 16 * c) = o; }
          LDS_WAIT(); asm volatile("" ::: "memory"); } }
    if (tid < 32) { const float am = __uint_as_float(cmax[tid]); sb[tid] = am > 0.f ? am * (1.0f / 127.0f) : 1.0f; }
    __syncthreads();
}
constexpr int SGU_LDV = 136;
constexpr int SGU_STATS_OFF = 2 * 128 * SGU_LDV * 2;
__device__ __forceinline__ void sgu_unit(int b, int chunk, int gp, const GAS bf16_t* U, const GAS bf16_t* VG, GAS bf16_t* OUT, const GAS float* gsgu, const GAS bf16_t* wst  , const GAS float* bs  , const GAS f32x2* vgst, LAS unsigned char* lds, const int tid) {
    const int lane = tid & 63, wid = __builtin_amdgcn_readfirstlane(tid >> 6);
    const int tok0 = b * SEQ + chunk * 128;
    LAS float* stats = (LAS float*)(lds + SGU_STATS_OFF);
    LAS bf16_t* vnT = (LAS bf16_t*)lds;
    if (tid < 128) { const GAS f32x4* p = (const GAS f32x4*)(vgst + (size_t)(tok0 + tid) * 16); float sm = 0.f, sq = 0.f;
#pragma unroll
        for (int i = 0; i < 8; ++i) { const f32x4 v = p[i]; sm += v.x + v.z; sq += v.y + v.w; }
        const float mean = sm * (1.0f / SW); const float var = fmaxf(sq * (1.0f / SW) - mean * mean, 0.f);
        stats[2 * tid] = mean; stats[2 * tid + 1] = 1.0f / sqrtf(var + EPS); }
    LDS_WAIT(); __syncthreads();
    { const int s = tid & 127, cq = tid >> 7; const float mean = stats[2 * s], rstd = stats[2 * s + 1];
#pragma unroll
      for (int gi = 0; gi < 2; ++gi) { const int g = 2 * gp + gi;
#pragma unroll
          for (int i = 0; i < 4; ++i) { const int d = 8 * (cq + 4 * i); const bf16x8 v = *(const GAS bf16x8*)(VG + (size_t)(tok0 + s) * SW + g * 128 + d);
              const f32x4 g0 = *(const GAS f32x4*)(gsgu + g * 128 + d), g1 = *(const GAS f32x4*)(gsgu + g * 128 + d + 4);
#pragma unroll
              for (int k = 0; k < 8; ++k) { const float gn = k < 4 ? g0[k & 3] : g1[k & 3]; const float y = (bf2f((unsigned short)v[k]) - mean) * rstd * gn;
                  vnT[(gi * 128 + d + k) * SGU_LDV + s] = (bf16_t)(cvt_pk_bf16(y, 0.f) & 0xffffu); } } } }
    LDS_WAIT(); __syncthreads();
    { const int gi = wid >> 2, tn = wid & 3, g = 2 * gp + gi, r = lane & 31, h = lane >> 5;
      f32x16 acc[4];
#pragma unroll
      for (int mt = 0; mt < 4; ++mt) acc[mt] = f32x16{};
      const GAS bf16_t* wrow = wst + ((size_t)g * 128 + 32 * tn + r) * 128 + 8 * h;
      const int nks = 2 * (tn + 1);
      bf16x8 bfr[8];
#pragma unroll
      for (int ks = 0; ks < 8; ++ks) if (ks < nks) bfr[ks] = *(const GAS bf16x8*)(wrow + 16 * ks);
      const int t = 32 * tn + r; const float bias = bs[g * 128 + t]; const size_t rowoff = (size_t)(tok0 + t) * SW + g * 128;
      u32x2 uu_[4][4];
#pragma unroll
      for (int mt = 0; mt < 4; ++mt)
#pragma unroll
          for (int q = 0; q < 4; ++q) uu_[mt][q] = *(const GAS u32x2*)(U + rowoff + 32 * mt + 8 * q + 4 * h);
#pragma unroll
      for (int ks = 0; ks < 8; ++ks) if (ks < nks) {
#pragma unroll
          for (int mt = 0; mt < 4; ++mt) { const bf16x8 afrag = *(const LAS bf16x8*)(vnT + (gi * 128 + 32 * mt + r) * SGU_LDV + 16 * ks + 8 * h);
              acc[mt] = __builtin_amdgcn_mfma_f32_32x32x16_bf16(afrag, bfr[ks], acc[mt], 0, 0, 0); } }
#pragma unroll
      for (int mt = 0; mt < 4; ++mt)
#pragma unroll
          for (int qp = 0; qp < 2; ++qp) { u32x2 w[2];
#pragma unroll
              for (int k = 0; k < 2; ++k) { const int q = 2 * qp + k; const u32x2 uu = uu_[mt][q];
                  const float o0 = bflo(uu.x) * (acc[mt][4 * q + 0] + bias), o1 = bfhi(uu.x) * (acc[mt][4 * q + 1] + bias), o2 = bflo(uu.y) * (acc[mt][4 * q + 2] + bias), o3 = bfhi(uu.y) * (acc[mt][4 * q + 3] + bias);
                  w[k].x = cvt_pk_bf16(o0, o1); w[k].y = cvt_pk_bf16(o2, o3); }
              const auto sx = __builtin_amdgcn_permlane32_swap(w[0].x, w[1].x, false, false); const auto sy = __builtin_amdgcn_permlane32_swap(w[0].y, w[1].y, false, false);
              u32x4 W; W.x = sx[0]; W.y = sy[0]; W.z = sx[1]; W.w = sy[1];
              *(GAS u32x4*)(OUT + rowoff + 32 * mt + 16 * qp + 8 * h) = W; } }
    __syncthreads();
}

struct Args { const float* in[19]; float* out; unsigned char* ws; int ph_lo, ph_hi; };
constexpr int NPHASE = 19;
#ifndef BG_UPFRONT
#define BG_UPFRONT 1
#endif
constexpr int GW_IN = BG_UPFRONT ? 256 : 231, GW_GU0 = BG_UPFRONT ? 256 : 235;

__device__ __forceinline__ int must_after(int, int) { return CV_TOTAL; }
#define PH_ENTER() int tid = TID0(); asm volatile("" : "+v"(tid)); const int lane = tid & 63, wave = __builtin_amdgcn_readfirstlane(tid >> 6); int bx = bx0; asm volatile("" : "+s"(bx)); \
    GAS unsigned char* ws = (GAS unsigned char*)args.ws; asm volatile("" : "+s"(ws)); const int vcu = (G % 8 == 0) ? (bx % 8) * (G / 8) + bx / 8 : bx; const int gw = vcu * 8 + wave, NGW = G * 8; (void)lane; (void)gw; (void)NGW
template <unsigned PHMASK> __global__ void __launch_bounds__(512, 2) mk_fwd(Args args) {
    extern __shared__ __attribute__((aligned(16))) unsigned char lds_raw[];
    LAS unsigned char* lds = (LAS unsigned char*)lds_raw;
    const int G = gridDim.x, bx0 = blockIdx.x;
    const int wave0 = __builtin_amdgcn_readfirstlane(threadIdx.x >> 6);
#define TID0() (wave0 * 64 + lane_id())
#define ctl ((unsigned*)args.ws)
#define MISC ((volatile LAS unsigned*)(lds + MISC_OFF))
    for (int u = threadIdx.x; u < (LDS_BYTES - RING_BYTES) / 4; u += 512) ((LAS unsigned*)(lds + RING_BYTES))[u] = 0u;
    __syncthreads();
    const int lo = args.ph_lo, hi = args.ph_hi;
    if (hi - lo > 1) (void)xcd_barrier_post((unsigned*)args.ws + CW_BAR, (volatile LAS unsigned*)(lds + MISC_OFF) + 8);
#define GRID_BARRIER() do { if (BAR2) { xcd_barrier2((unsigned*)args.ws + CW_BAR, xb_xcc_id(), (volatile LAS unsigned*)(lds + MISC_OFF) + 8, TID0()); break; } XcdBarrier b_; b_.bar = (unsigned*)args.ws + CW_BAR; b_.x = xb_xcc_id(); b_.st = (volatile LAS unsigned*)(lds + MISC_OFF) + 8; xcd_barrier(b_, TID0() == 0); } while (0)
#define IN(k) (((PHMASK >> (((k) >= 10) ? (k) - 9 : (k))) & 1u) && lo <= (k) && (k) < hi)
#define SEAM(k) do { if (IN(k) && IN((k) + 1)) GRID_BARRIER(); } while (0)
#define RUN(k) (IN(pb + (k)) && (!ex || ((EXMASK >> (k)) & 1u)))
#define SEAM_BG(k, must, LOOKF, NLOOK) do { if (IN(k) && IN((k) + 1)) { if (BG_UPFRONT) { GRID_BARRIER(); break; } PH_ENTER(); if (tid == 0) (void)__hip_atomic_fetch_add(ctl + CW_DONE + 64 * (k), 1u, __ATOMIC_RELAXED, __HIP_MEMORY_SCOPE_AGENT); \
        bg_convert<LOOKF>(args.in, ws, ctl, lds, MISC + 12, lane, wave, bx, G, (must), (k), (NLOOK)); GRID_BARRIER(); } } while (0)
#define SEAMX(k) do { if (!ex) { SEAM_BG(pb + (k), must_after(l, (k)), (!BG_UPFRONT && ((k) == 0 || (k) == 1 || (k) == 6)), ((k) == 1 ? 2 : 7)); } else if (RUN(k)) GRID_BARRIER(); } while (0)

    if (IN(0)) {
        { PH_ENTER();
        bg_convert<false>(args.in, ws, ctl, lds, MISC + 12, lane, wave, bx, G, CV_TOTAL, 0, 0);
        __syncthreads();
        for (;;) {
            if (tid == 0) MISC[16] = __hip_atomic_fetch_add(ctl + CW_Q8Q, 1u, __ATOMIC_RELAXED, __HIP_MEMORY_SCOPE_AGENT);
            LDS_WAIT(); __syncthreads();
            const int sidx = (int)MISC[16];
            __syncthreads();
            if (sidx >= Q8_STRIPS + Q8D_STRIPS) break;
            int tq = tid; asm volatile("" : "+v"(tq));
            if (sidx >= Q8D_STRIPS) q8_strip(args.in, ws, lds, sidx - Q8D_STRIPS, tq); else if (Q8D_REG) q8_strip_down_reg(args.in, ws, lds, sidx, tq); else q8_strip_down(args.in, ws, lds, sidx, tq);
        }
#ifdef P0X_LO
        GRID_BARRIER();
        for (;;) {
            if (tid == 0) MISC[16] = P0X_LO + __hip_atomic_fetch_add(ctl + CW_Q8Q + 64, 1u, __ATOMIC_RELAXED, __HIP_MEMORY_SCOPE_AGENT);
            LDS_WAIT(); __syncthreads();
            const int sidx = (int)MISC[16];
            __syncthreads();
            if (sidx >= P0X_HI) break;
            int tq = tid; asm volatile("" : "+v"(tq));
            if (sidx < Q8_STRIPS) q8_strip(args.in, ws, lds, sidx, tq); else if (Q8D_REG) q8_strip_down_reg(args.in, ws, lds, sidx - Q8_STRIPS, tq); else q8_strip_down(args.in, ws, lds, sidx - Q8_STRIPS, tq);
        }
        GRID_BARRIER();
#endif
        }
        PH_ENTER();
        { const GAS float* wsrc = (const GAS float*)args.in[4]; GAS bf16_t* wdst = (GAS bf16_t*)(ws + WS_WS);
          for (int i = vcu * 512 + tid; i < 2 * 8 * 128 * 128; i += G * 512) { const int s = i & 127, t = (i >> 7) & 127; const float v = s <= t ? wsrc[i] : 0.f; wdst[i] = (bf16_t)(cvt_pk_bf16(v, 0.f) & 0xffffu); } }
        const GAS float* x_in = (const GAS float*)args.in[0];
        { GAS unsigned* H8 = (GAS unsigned*)(ws + WS_H); GAS float* SA = (GAS float*)(ws + WS_SB + 512 * 1024);
          for (int m = gw; m < NTOK; m += NGW) { f32x4 v[8]; rms_row(x_in + (size_t)m * DM, lane, v); store_row_i8((GAS unsigned*)((GAS unsigned char*)H8 + (size_t)m * P8B), SA + m, lane, v); } }
    }
    SEAM_BG(0, CV_END_WIN0, false, 0);

    for (int li = 0; li < (EXMASK ? 3 : 2); ++li) {
        const int l = li < 2 ? li : 1; const bool ex = li >= 2;
        const int pb = 1 + 9 * l;
        if (ex) GRID_BARRIER();
        if (RUN(0)) {
            PH_ENTER();
            pg8::Gemm g{(const bf16_t*)(ws + WS_H), (const bf16_t*)(ws + WS_WIN + (size_t)l * INW * P8B), NTOK, INW, DM / 2, P8B / 2, P8B / 2}; const int Gw = (G == 256) ? GW_IN : G;
            if (bx < Gw) { pg8::StaticOrder S; S.init(NTOK, INW, Gw, bx);
            pg8::EpiIn E{(const GAS float*)(ws + WS_SB + 512 * 1024), (const GAS float*)(ws + WS_SB) + SB_WIN + l * INW, (GAS bf16_t*)(ws + WS_QKVUV), (GAS bf16_t*)(ws + WS_GAB), (GAS float*)(ws + WS_RT + RT_KSUM), (GAS f32x2*)(ws + WS_P1)};
            pg8::gemm_phase<pg8::EpiIn, pg8::StaticOrder, true, true, true>(lds, g, S, E, tid); }
        }
        SEAMX(0);
        if (RUN(1)) {
            PH_ENTER();
            GAS bf16_t* QKVUV = (GAS bf16_t*)(ws + WS_QKVUV);
            const GAS bf16_t* Qb = QKVUV; const GAS bf16_t* Kb = QKVUV + (size_t)NTOK * 1024; const GAS bf16_t* Vb = QKVUV + (size_t)2 * NTOK * 1024;
            const GAS bf16_t* Ub = QKVUV + (size_t)3 * NTOK * 1024; const GAS bf16_t* VGb = QKVUV + (size_t)4 * NTOK * 1024;
#if ATT_KV2
            for (int a = bx; a < 256; a += G) { const int i = a >> 3; const int bh = (a & 7) * 4 + (i >> 3), j = i & 7;
#pragma unroll 1
                for (int uu = 0; uu < 2; ++uu) { const int idx = uu ? 15 - j : j; int ta = tid; asm volatile("" : "+v"(ta));
                    att::attn_unit3(bh >> 3, bh & 7, idx >> 1, idx & 1, Qb, Kb, Vb, (GAS bf16_t*)(ws + WS_ATT), (const GAS float*)(ws + WS_RT + RT_KSUM), (char*)lds_raw, ta); } }
#else
            for (int a = bx; a < 256; a += G) { const int i = a >> 3; const int bh = (a & 7) * 4 + (i >> 3), qb = i & 7;
                att::attn_unit(bh >> 3, bh & 7, qb, Qb, Kb, Vb, (GAS bf16_t*)(ws + WS_ATT), (const GAS float*)(ws + WS_RT + RT_KSUM), (char*)lds_raw, tid); }
#endif
            __syncthreads();
            const GAS float* gsgu = (const GAS float*)args.in[3] + l * SW; const GAS bf16_t* wst = (const GAS bf16_t*)(ws + WS_WS) + (size_t)l * 8 * 128 * 128; const GAS float* bs = (const GAS float*)args.in[5] + l * 8 * 128;
            GAS bf16_t* SGUO = (GAS bf16_t*)(ws + WS_SGU);
#if ATT_KV2
            if (G == 256) { const int sidx = (bx & 7) * 32 + (bx >> 3); int ts = tid; asm volatile("" : "+v"(ts));
                sgu_unit(sidx >> 6, (sidx >> 2) & 15, sidx & 3, Ub, VGb, SGUO, gsgu, wst, bs, (const GAS f32x2*)(ws + WS_P1), lds, ts); }
            else
#endif
            if (G == 256) { const int i = bx >> 3, qb = i & 7;
                if (qb < 4) { const int lr = (bx & 7) + 8 * ((i >> 3) * 4 + qb);
                    for (int s = lr; s < 256; s += 128) sgu_unit(s >> 6, (s >> 2) & 15, s & 3, Ub, VGb, SGUO, gsgu, wst, bs, (const GAS f32x2*)(ws + WS_P1), lds, tid); } }
            else { for (int s = bx; s < 256; s += G) sgu_unit(s >> 6, (s >> 2) & 15, s & 3, Ub, VGb, SGUO, gsgu, wst, bs, (const GAS f32x2*)(ws + WS_P1), lds, tid); }
        }
        SEAMX(1);
        if (RUN(2)) {
            PH_ENTER();
            pg8::Gemm g{(const bf16_t*)(ws + WS_ATT), (const bf16_t*)(ws + WS_WPA) + (size_t)l * 2 * DM * AW, 2 * NTOK, 2 * DM, AW};
            pg8::PairOrder S; S.init(NTOK, DM, G, bx); S.a_off = NTOK / 256; S.b_off = DM / 256;
            pg8::EpiMrg E{(const GAS unsigned char*)(ws + WS_GAB), (const GAS unsigned char*)(ws + WS_GAB) + (size_t)NTOK * 2048, (GAS bf16_t*)(ws + WS_MRG)};
            pg8::gemm_phase<pg8::EpiMrg, pg8::PairOrder, true, true>(lds, g, S, E, tid);
        }
        SEAMX(2);
        if (RUN(3)) {
            PH_ENTER();
            pg8::Gemm g{(const bf16_t*)(ws + WS_MRG), (const bf16_t*)(ws + WS_WO) + (size_t)l * DM * DM, NTOK, DM, DM}; pg8::StaticOrder S; S.init(NTOK, DM, G, bx);
            if (l == 0) { pg8::EpiRes<true> E{(const GAS float*)args.in[0], nullptr, (GAS bf16_t*)(ws + WS_X)}; pg8::gemm_phase<pg8::EpiRes<true>, pg8::StaticOrder, true, true>(lds, g, S, E, tid); }
            else { pg8::EpiRes<false> E{nullptr, (const GAS bf16_t*)(ws + WS_X), (GAS bf16_t*)(ws + WS_X)}; pg8::gemm_phase<pg8::EpiRes<false>, pg8::StaticOrder, true, true>(lds, g, S, E, tid); }
        }
        SEAMX(3);
        if (RUN(4)) {
            PH_ENTER();
            const GAS bf16_t* X = (const GAS bf16_t*)(ws + WS_X);
            if (l == 0) { GAS unsigned* H8 = (GAS unsigned*)(ws + WS_H); GAS float* SA = (GAS float*)(ws + WS_SB + 512 * 1024);
                for (int m = gw; m < NTOK; m += NGW) { f32x4 v[8]; rms_row_bf(X + (size_t)m * DM, lane, v); store_row_i8((GAS unsigned*)((GAS unsigned char*)H8 + (size_t)m * P8B), SA + m, lane, v); } }
            else { const GAS float* gain = (const GAS float*)args.in[9] + DM; const GAS float* wr = (const GAS float*)args.in[13]; const GAS float* br = (const GAS float*)args.in[14];
                GAS int* TE = (GAS int*)(ws + WS_RT + RT_TE); GAS int* TP = (GAS int*)(ws + WS_RT + RT_TP); GAS float* TW = (GAS float*)(ws + WS_RT + RT_TW);
                if (G == 256) {
                    GAS bf16_t* XG = (GAS bf16_t*)(ws + WS_XG); GAS int* TS = (GAS int*)(ws + WS_RT + RT_TS); GAS float* CWT = (GAS float*)(ws + WS_RT + RT_CW);
                    LAS float* wrt = (LAS float*)lds;
                    for (int k = tid; k < DM; k += 512) { const f32x4 a = *(const GAS f32x4*)(wr + (size_t)k * 8), b = *(const GAS f32x4*)(wr + (size_t)k * 8 + 4);
                        wrt[0 * DM + k] = a.x; wrt[1 * DM + k] = a.y; wrt[2 * DM + k] = a.z; wrt[3 * DM + k] = a.w; wrt[4 * DM + k] = b.x; wrt[5 * DM + k] = b.y; wrt[6 * DM + k] = b.z; wrt[7 * DM + k] = b.w; }
                    LDS_WAIT(); __syncthreads();
                    unsigned hr[4][8]; float rsa[4]; int re0[4], re1[4], rp0[4], rp1[4]; float rw0[4], rw1[4];
                    GAS float* SAG = (GAS float*)(ws + WS_SB + 640 * 1024);
#pragma unroll
                    for (int i = 0; i < 4; ++i) { const int m = gw + i * NGW; f32x4 v[8]; rms_row_bf(X + (size_t)m * DM, lane, v);
                        { float am = 0.f;
#pragma unroll
                          for (int j = 0; j < 8; ++j) am = fmaxf(am, fmaxf(fmaxf(fabsf(v[j].x), fabsf(v[j].y)), fmaxf(fabsf(v[j].z), fabsf(v[j].w))));
                          am = wave_max(am); const float inv = am > 0.f ? 127.0f / am : 0.f; float rs_ = am > 0.f ? am * (1.0f / 127.0f) : 1.0f; asm volatile("" : "+v"(rs_)); rsa[i] = rs_;
#pragma unroll
                          for (int j = 0; j < 8; ++j) { unsigned pk_ = pack_i8x4(v[j], inv); asm volatile("" : "+v"(pk_)); hr[i][j] = pk_; } }
                        const GAS f32x4* gr = (const GAS f32x4*)gain + lane;
                        float lg[8];
#pragma unroll
                        for (int e = 0; e < 8; ++e) lg[e] = 0.f;
#pragma unroll
                        for (int j = 0; j < 8; ++j) { const f32x4 hg = v[j] * gr[64 * j];
#pragma unroll
                            for (int e = 0; e < 8; ++e) { const f32x4 w4 = *(const LAS f32x4*)(wrt + e * DM + 4 * lane + 256 * j); lg[e] += (hg.x * w4.x + hg.y * w4.y) + (hg.z * w4.z + hg.w * w4.w); } }
#pragma unroll
                        for (int e = 0; e < 8; ++e) lg[e] = wave_sum(lg[e]) + br[e];
                        int e0 = 0; float v0 = lg[0];
#pragma unroll
                        for (int e = 1; e < 8; ++e) if (lg[e] > v0) { v0 = lg[e]; e0 = e; }
                        int e1 = e0 == 0 ? 1 : 0; float v1 = -__builtin_inff();
#pragma unroll
                        for (int e = 0; e < 8; ++e) if (e != e0 && lg[e] > v1) { v1 = lg[e]; e1 = e; }
                        const float ex = __expf(v1 - v0);
                        unsigned p0 = 0u, p1 = 0u; if (lane == 0) { p0 = atomicAdd(ctl + CW_CNT + 64 * e0, 1u); p1 = atomicAdd(ctl + CW_CNT + 64 * e1, 1u); }
                        re0[i] = e0; re1[i] = e1; rp0[i] = (int)__builtin_amdgcn_readfirstlane(p0); rp1[i] = (int)__builtin_amdgcn_readfirstlane(p1); { float a_ = 1.0f / (1.0f + ex), b_ = ex / (1.0f + ex); asm volatile("" : "+v"(a_), "+v"(b_)); rw0[i] = a_; rw1[i] = b_; }
                        asm volatile("" ::: "memory"); }
                    asm volatile("s_waitcnt vmcnt(0)" ::: "memory"); __syncthreads();
                    if (tid == 0) { (void)__hip_atomic_fetch_add(ctl + CW_ROUTED, 1u, __ATOMIC_RELAXED, __HIP_MEMORY_SCOPE_AGENT); unsigned sp = 0;
                        while (__hip_atomic_load(ctl + CW_ROUTED, __ATOMIC_RELAXED, __HIP_MEMORY_SCOPE_AGENT) < (unsigned)G) { __builtin_amdgcn_s_sleep(1); if (++sp > (1u << 22)) break; } }
                    __syncthreads();
                    int rb[8]; { int acc = 0;
#pragma unroll
                        for (int e = 0; e < 8; ++e) { rb[e] = acc; acc += (int)(((__builtin_amdgcn_readfirstlane(__hip_atomic_load(ctl + CW_CNT + 64 * e, __ATOMIC_RELAXED, __HIP_MEMORY_SCOPE_AGENT)) + 255u) >> 8) << 8); } }
#pragma unroll
                    for (int i = 0; i < 4; ++i) { const int m = gw + i * NGW; int b0 = 0, b1 = 0;
#pragma unroll
                        for (int e = 0; e < 8; ++e) { b0 = (e == re0[i]) ? rb[e] : b0; b1 = (e == re1[i]) ? rb[e] : b1; }
                        const int s0 = b0 + rp0[i], s1 = b1 + rp1[i];
                        GAS unsigned* d0 = (GAS unsigned*)((GAS unsigned char*)XG + (size_t)s0 * P8B) + lane; GAS unsigned* d1 = (GAS unsigned*)((GAS unsigned char*)XG + (size_t)s1 * P8B) + lane;
#pragma unroll
                        for (int j = 0; j < 8; ++j) { d0[64 * j] = hr[i][j]; d1[64 * j] = hr[i][j]; }
                        if (lane == 0) { TS[2 * m] = s0; TS[2 * m + 1] = s1; CWT[s0] = rw0[i]; CWT[s1] = rw1[i]; SAG[s0] = rsa[i]; SAG[s1] = rsa[i]; } }
                } }
        }
        SEAMX(4);
        if (RUN(6)) {
            PH_ENTER();
            const int Gw = (G == 256 && l == 0) ? GW_GU0 : G;
            if (bx < Gw) {
            pg8::GroupOrder S; S.init(l == 0 ? nullptr : (const unsigned*)(ctl + CW_CNT), 44, Gw, bx);
            if (G == 256) {
            pg8::Gemm g{l == 0 ? (const bf16_t*)(ws + WS_H) : (const bf16_t*)(ws + WS_XG), l == 0 ? (const bf16_t*)(ws + WS_WGU) : (const bf16_t*)(ws + WS_WEGU), 0, 0, DM / 2, P8B / 2, P8B / 2};
            pg8::EpiGU8 E{(GAS bf16_t*)(ws + WS_ACT), 44, (const GAS float*)(ws + WS_SB + (l == 0 ? 512 : 640) * 1024), (const GAS float*)(ws + WS_SB) + (l == 0 ? 0 : 11264)};
            pg8::gemm_phase<pg8::EpiGU8, pg8::GroupOrder, true, true, true>(lds, g, S, E, tid);
            } }
        }
        SEAMX(6);
        if (RUN(7)) {
            PH_ENTER();
            int nrows = 0;
#pragma unroll
            for (int e = 0; e < 8; ++e) nrows += (int)(((__builtin_amdgcn_readfirstlane(__hip_atomic_load(ctl + CW_CNT + 64 * e, __ATOMIC_RELAXED, __HIP_MEMORY_SCOPE_AGENT)) + 255u) >> 8) << 8);
            if (l == 0) nrows = NTOK;
            GAS float* SACT = (GAS float*)(ws + WS_SB + 768 * 1024); const GAS float* CWT = (const GAS float*)(ws + WS_RT + RT_CW);
            for (int r = gw; r < nrows; r += NGW) { GAS unsigned char* rowp = ws + WS_ACT + (size_t)r * (FF * 2); u32x4 v[11];
#pragma unroll
                for (int j = 0; j < 11; ++j) v[j] = *(const GAS u32x4*)(rowp + lane * 16 + j * 1024);
                float am = 0.f;
#pragma unroll
                for (int j = 0; j < 11; ++j) am = fmaxf(am, fmaxf(fmaxf(fmaxf(fabsf(bflo(v[j].x)), fabsf(bfhi(v[j].x))), fmaxf(fabsf(bflo(v[j].y)), fabsf(bfhi(v[j].y)))), fmaxf(fmaxf(fabsf(bflo(v[j].z)), fabsf(bfhi(v[j].z))), fmaxf(fabsf(bflo(v[j].w)), fabsf(bfhi(v[j].w))))));
                am = wave_max(am); const float inv = am > 0.f ? 127.0f / am : 0.f;
#pragma unroll
                for (int j = 0; j < 11; ++j) { u32x2 o; o.x = pack_i8x4((f32x4){bflo(v[j].x), bfhi(v[j].x), bflo(v[j].y), bfhi(v[j].y)}, inv); o.y = pack_i8x4((f32x4){bflo(v[j].z), bfhi(v[j].z), bflo(v[j].w), bfhi(v[j].w)}, inv);
                    *(GAS u32x2*)(rowp + lane * 8 + j * 512) = o; }
                if (lane == 0) SACT[r] = (am > 0.f ? am * (1.0f / 127.0f) : 1.0f) * (l == 1 ? CWT[r] : 1.0f); }
            GRID_BARRIER();
        }
        if (RUN(7)) {
            PH_ENTER();
            if (l == 0) {
            pg8::DownOrderT<44> S; S.init(nullptr, G, bx);
            pg8::Gemm g{(const bf16_t*)(ws + WS_ACT), (const bf16_t*)(ws + WS_WD), 0, 0, FF / 2, FF, FF};
            pg8::EpiResX8 E{(const GAS float*)(ws + WS_SB + 768 * 1024), (const GAS float*)(ws + WS_SB) + SB_WD, (GAS bf16_t*)(ws + WS_X)};
            pg8::gemm_phase<pg8::EpiResX8, pg8::DownOrderT<44>, true, true, true>(lds, g, S, E, tid);
            } else {
            pg8::DownOrderT<44> S; S.init((const unsigned*)(ctl + CW_CNT), G, bx);
            pg8::Gemm g{(const bf16_t*)(ws + WS_ACT), (const bf16_t*)(ws + WS_WED), 0, 0, FF / 2, FF, FF};
            pg8::EpiRes8 E{(const GAS float*)(ws + WS_SB + 768 * 1024), (const GAS float*)(ws + WS_SB) + SB_WED, (GAS bf16_t*)(ws + WS_YP), S.psplit0 * 256, (GAS bf16_t*)(ws + WS_Y)};
            pg8::gemm_phase<pg8::EpiRes8, pg8::DownOrderT<44>, true, true, true>(lds, g, S, E, tid);
            }
        }
        SEAMX(7);
        if (RUN(8)) {
            PH_ENTER();
            const GAS bf16_t* X = (const GAS bf16_t*)(ws + WS_X);
            if (l == 0) { GAS unsigned* H8 = (GAS unsigned*)(ws + WS_H); GAS float* SA = (GAS float*)(ws + WS_SB + 512 * 1024); for (int m = gw; m < NTOK; m += NGW) { f32x4 v[8]; rms_row_bf(X + (size_t)m * DM, lane, v); store_row_i8((GAS unsigned*)((GAS unsigned char*)H8 + (size_t)m * P8B), SA + m, lane, v); } }
            else { const GAS float* gain = (const GAS float*)args.in[18]; const GAS bf16_t* Y = (const GAS bf16_t*)(ws + WS_Y); const GAS int* TS = (const GAS int*)(ws + WS_RT + RT_TS);
                const GAS bf16_t* YP = (const GAS bf16_t*)(ws + WS_YP);
                int split_row0; { int P = 0;
#pragma unroll
                    for (int e = 0; e < 8; ++e) P += (int)((__builtin_amdgcn_readfirstlane(__hip_atomic_load(ctl + CW_CNT + 64 * e, __ATOMIC_RELAXED, __HIP_MEMORY_SCOPE_AGENT)) + 255u) >> 8);
                    split_row0 = (P - pg8::moe_split_r(P, G)) * 256; }
                for (int m = gw; m < NTOK; m += NGW) { const int s0 = TS[2 * m], s1 = TS[2 * m + 1];
                    const GAS u32x2* xr = (const GAS u32x2*)(X + (size_t)m * DM) + lane; const GAS u32x2* y0 = (const GAS u32x2*)(Y + (size_t)s0 * DM) + lane; const GAS u32x2* y1 = (const GAS u32x2*)(Y + (size_t)s1 * DM) + lane;
                    f32x4 v[8]; float s = 0.f;
#pragma unroll
                    for (int j = 0; j < 8; ++j) { const u32x2 a = y0[64 * j], b = y1[64 * j], xw = xr[64 * j]; v[j] = (f32x4){bflo(xw.x), bfhi(xw.x), bflo(xw.y), bfhi(xw.y)} + (f32x4){bflo(a.x), bfhi(a.x), bflo(a.y), bfhi(a.y)} + (f32x4){bflo(b.x), bfhi(b.x), bflo(b.y), bfhi(b.y)}; }
                    if (s0 >= split_row0) { const GAS u32x2* p = (const GAS u32x2*)(YP + (size_t)(s0 - split_row0) * DM) + lane;
#pragma unroll
                        for (int j = 0; j < 8; ++j) { const u32x2 a = p[64 * j], b = p[64 * j + (size_t)2048 * DM / 4], c = p[64 * j + (size_t)2 * 2048 * DM / 4];
                            v[j] += ((f32x4){bflo(a.x), bfhi(a.x), bflo(a.y), bfhi(a.y)} + (f32x4){bflo(b.x), bfhi(b.x), bflo(b.y), bfhi(b.y)}) + (f32x4){bflo(c.x), bfhi(c.x), bflo(c.y), bfhi(c.y)}; } }
                    if (s1 >= split_row0) { const GAS u32x2* p = (const GAS u32x2*)(YP + (size_t)(s1 - split_row0) * DM) + lane;
#pragma unroll
                        for (int j = 0; j < 8; ++j) { const u32x2 a = p[64 * j], b = p[64 * j + (size_t)2048 * DM / 4], c = p[64 * j + (size_t)2 * 2048 * DM / 4];
                            v[j] += ((f32x4){bflo(a.x), bfhi(a.x), bflo(a.y), bfhi(a.y)} + (f32x4){bflo(b.x), bfhi(b.x), bflo(b.y), bfhi(b.y)}) + (f32x4){bflo(c.x), bfhi(c.x), bflo(c.y), bfhi(c.y)}; } }
#pragma unroll
                    for (int j = 0; j < 8; ++j) s += (v[j].x * v[j].x + v[j].y * v[j].y) + (v[j].z * v[j].z + v[j].w * v[j].w);
                    const float rstd = 1.0f / sqrtf(wave_sum(s) * (1.0f / DM) + EPS);
                    const GAS f32x4* gr = (const GAS f32x4*)gain + lane; GAS f32x4* orow = (GAS f32x4*)((GAS float*)args.out + (size_t)m * DM) + lane;
#pragma unroll
                    for (int j = 0; j < 8; ++j) orow[64 * j] = v[j] * rstd * gr[64 * j]; } }
        }
        if (l == 0 || EXMASK) SEAMX(8);
    }
#undef IN
#undef SEAM
}

template <unsigned MASK> static bool setup_one() {
    if (hipFuncSetAttribute((const void*)mk_fwd<MASK>, hipFuncAttributeMaxDynamicSharedMemorySize, LDS_BYTES) != hipSuccess) { fprintf(stderr, "kernel_launch: hipFuncSetAttribute failed (mask %x)\n", MASK); return false; }
    return true;
}
template <unsigned MASK> static void launch_one(int grid, hipStream_t stream, const Args& a) { hipLaunchKernelGGL(mk_fwd<MASK>, dim3(grid), dim3(512), LDS_BYTES, stream, a); }
extern "C" void kernel_launch(void* const* d_in, const int* in_sizes, int n_in, void* d_out, int out_size, void* d_ws, size_t ws_size, hipStream_t stream) {
    static int grid = 0;
    if (grid == 0) {
        if (n_in != 19 || out_size != NTOK * DM || ws_size < WS_END) { fprintf(stderr, "kernel_launch: unexpected shapes (n_in %d out %d ws %zu need %zu)\n", n_in, out_size, ws_size, (size_t)WS_END); grid = -1; return; }
        int dev = 0, cus = 0;
        if (hipGetDevice(&dev) != hipSuccess || hipDeviceGetAttribute(&cus, hipDeviceAttributeMultiprocessorCount, dev) != hipSuccess) { grid = -1; return; }
#if MK_ONE_LAUNCH
        bool ok = setup_one<0xFFFFFFFFu>();
        int per_cu = 0; if (hipOccupancyMaxActiveBlocksPerMultiprocessor(&per_cu, (const void*)mk_fwd<0xFFFFFFFFu>, 512, LDS_BYTES) != hipSuccess || per_cu < 1) fprintf(stderr, "kernel_launch: occupancy query says %d\n", per_cu);
#else
        bool ok = setup_one<1u>() && setup_one<2u>() && setup_one<4u>() && setup_one<8u>() && setup_one<16u>() && setup_one<32u>() && setup_one<64u>() && setup_one<128u>() && setup_one<256u>() && setup_one<512u>();
#endif
        (void)hipGetLastError();
        if (!ok) { grid = -1; return; }
        if (cus != 256) { fprintf(stderr, "kernel_launch: this build is laid out for 256 CUs (found %d); nothing launched\n", cus); grid = -1; return; }
        grid = cus;
    }
    if (grid < 0) return;
    (void)hipMemsetAsync((char*)d_ws + WS_CTL, 0, 1 * MiB, stream);
    Args a{};
    for (int i = 0; i < 19; ++i) a.in[i] = (const float*)d_in[i];
    a.out = (float*)d_out; a.ws = (unsigned char*)d_ws;
#if MK_ONE_LAUNCH
    a.ph_lo = 0; a.ph_hi = NPHASE;
    launch_one<0xFFFFFFFFu>(grid, stream, a);
#else
    for (int p = 0; p < NPHASE; ++p) { if (p == 6) continue;
        a.ph_lo = p; a.ph_hi = p + 1;
        const int bit = p >= 10 ? p - 9 : p;
        switch (bit) {
            case 0: launch_one<1u>(grid, stream, a); break; case 1: launch_one<2u>(grid, stream, a); break; case 2: launch_one<4u>(grid, stream, a); break;
            case 3: launch_one<8u>(grid, stream, a); break; case 4: launch_one<16u>(grid, stream, a); break; case 5: launch_one<32u>(grid, stream, a); break;
            case 6: launch_one<64u>(grid, stream, a); break; case 7: launch_one<128u>(grid, stream, a); break; case 8: launch_one<256u>(grid, stream, a); break;
            default: launch_one<512u>(grid, stream, a); break; } }
#endif
}
```

```cpp
#include <hip/hip_runtime.h>
#include <cstdio>
#include <cstdint>

#ifndef DBL_P0
#define DBL_P0 1
#endif
#ifndef ATT_KV2
#define ATT_KV2 1
#endif
#ifndef EXMASK
#define EXMASK 0x0u
#endif
#ifndef MK_ONE_LAUNCH
#define MK_ONE_LAUNCH 1
#endif

#define LAS __attribute__((address_space(3)))
#define GAS __attribute__((address_space(1)))
typedef unsigned short bf16_t;
typedef short bf16x8 __attribute__((ext_vector_type(8)));
typedef short s16x4 __attribute__((ext_vector_type(4)));
typedef float f32x2 __attribute__((ext_vector_type(2)));
typedef float f32x4 __attribute__((ext_vector_type(4)));
typedef float f32x16 __attribute__((ext_vector_type(16)));
typedef unsigned u32x2 __attribute__((ext_vector_type(2)));
typedef unsigned u32x4 __attribute__((ext_vector_type(4)));
typedef int i32x4 __attribute__((ext_vector_type(4)));

constexpr int NTOK = 8192, DM = 2048, SEQ = 2048, NBATCH = 4, NHEAD = 8, HDIM = 128, AW = 1024, SW = 1024, INW = 9216, FF = 5632, NEXP = 8;
constexpr int NSLOT = 18432;
constexpr float EPS = 1e-6f;

constexpr size_t MiB = 1u << 20;
constexpr size_t WS_CTL = 0;
constexpr size_t WS_WIN = 1 * MiB;
constexpr size_t WS_WPA = WS_WIN + 72 * MiB;
constexpr size_t WS_WPB = WS_WPA + 8 * MiB;
constexpr size_t WS_WO = WS_WPB + 8 * MiB;
constexpr size_t WS_WGU = WS_WO + 16 * MiB;
constexpr size_t WS_WD = WS_WGU + 44 * MiB;
constexpr size_t WS_WEGU = WS_WD + 22 * MiB;
constexpr size_t WS_WED = WS_WEGU + 352 * MiB;
constexpr size_t WS_WS = WS_WED + 176 * MiB;
constexpr size_t WS_X = WS_WS + 1 * MiB;
constexpr size_t WS_H = WS_X + 64 * MiB;
constexpr size_t WS_RT = WS_H + 32 * MiB;
constexpr size_t WS_R = WS_RT + 1 * MiB;
constexpr size_t WS_QKVUV = WS_R;
constexpr size_t WS_GAB = WS_R + 80 * MiB;
constexpr size_t WS_ATT = WS_R + 144 * MiB;
constexpr size_t WS_SGU = WS_R + 160 * MiB;
constexpr size_t WS_P1 = WS_R + 176 * MiB;
constexpr size_t WS_MRG = WS_R + 240 * MiB;
constexpr size_t WS_ACT = WS_R;
constexpr size_t WS_XG = WS_R + 198 * MiB;
constexpr size_t WS_Y = WS_R + 270 * MiB;
constexpr size_t WS_YP = WS_R + 414 * MiB;
constexpr size_t WS_SB = WS_YP + 48 * MiB;
constexpr int SB_WIN = 9 * 11264;
constexpr int SB_WD = 896 * 256 + 8 * 2048;
constexpr int SB_WED = 896 * 256;
constexpr size_t WS_END = WS_SB + 1 * MiB;
constexpr size_t RT_TE = 0, RT_TP = 65536, RT_TW = 131072, RT_TS = 196608, RT_CW = 262144, RT_KSUM = 524288;

constexpr int CW_CNT = 64;
constexpr int CW_Q8Q = 3072;
constexpr int CW_ROUTED = 2048;
constexpr int CW_BAR = 4096;
constexpr int CW_QH = 8192;
constexpr int CW_DONE = 16384;

#ifndef P8
#define P8 2176
#endif
constexpr int P8B = P8;
constexpr int RING_BYTES = 131072;
constexpr int MISC_OFF = RING_BYTES + 320;
constexpr int SCL_OFF = RING_BYTES + 4096;
constexpr int LDS_BYTES = 147456;

__device__ __forceinline__ unsigned cvt_pk_bf16(float lo, float hi) { unsigned r; asm volatile("v_cvt_pk_bf16_f32 %0, %1, %2" : "=v"(r) : "v"(lo), "v"(hi)); return r; }
__device__ __forceinline__ float bf2f(unsigned short b) { return __uint_as_float(((unsigned)b) << 16); }
__device__ __forceinline__ float bflo(unsigned w) { return __uint_as_float(w << 16); }
__device__ __forceinline__ float bfhi(unsigned w) { return __uint_as_float(w & 0xffff0000u); }
__device__ __forceinline__ float sigmoid_f(float x) { return __builtin_amdgcn_rcpf(1.0f + __builtin_amdgcn_exp2f(-1.4426950408889634f * x)); }
__device__ __forceinline__ float silu_f(float x) { return x * sigmoid_f(x); }
__device__ __forceinline__ float gelu_f(float x) { const float y = 0.7978845608028654f * (x + 0.044715f * x * x * x); return x * __builtin_amdgcn_rcpf(1.0f + __builtin_amdgcn_exp2f(-2.8853900817779268f * y)); }
__device__ __forceinline__ float wave_sum(float v) {
#pragma unroll
    for (int o = 1; o < 64; o <<= 1) v += __shfl_xor(v, o);
    return v;
}
__device__ __forceinline__ float wave_max(float v) {
#pragma unroll
    for (int o = 1; o < 64; o <<= 1) v = fmaxf(v, __shfl_xor(v, o));
    return v;
}
__device__ __forceinline__ unsigned pack_i8x4(f32x4 v, float inv) {
    const unsigned a = __float_as_uint(__builtin_fmaf(v.x, inv, 12582912.0f)), b = __float_as_uint(__builtin_fmaf(v.y, inv, 12582912.0f));
    const unsigned c = __float_as_uint(__builtin_fmaf(v.z, inv, 12582912.0f)), d = __float_as_uint(__builtin_fmaf(v.w, inv, 12582912.0f));
    return __builtin_amdgcn_perm(b, a, 0x0c0c0400u) | (__builtin_amdgcn_perm(d, c, 0x0c0c0400u) << 16);
}
__device__ __forceinline__ int lane_id() { int r; asm volatile("v_mbcnt_lo_u32_b32 %0, -1, 0\n\tv_mbcnt_hi_u32_b32 %0, -1, %0" : "=v"(r)); return r; }
#define LDS_WAIT() asm volatile("s_waitcnt lgkmcnt(0)" ::: "memory")
#define VM_WAIT() asm volatile("s_waitcnt vmcnt(0)" ::: "memory")

namespace pg8 {
constexpr int BM = 256, BK = 64, HALF = 128, HTB = HALF * BK * 2, STAGE_BYTES = 8 * HTB, NXCD = 8, WGM = 8;
__host__ __device__ __forceinline__ int lds_byte(int r, int c) { const int st = (r >> 4) * 2 + (c >> 5), rr = r & 15, cc = c & 31, ob = rr * 64 + cc * 2; return st * 1024 + (ob ^ (((ob >> 9) & 1) << 5)); }
__host__ __device__ __forceinline__ void stage_rc(int b, int& R, int& C) { const int st = b / 1024, sb = b % 1024, swz = sb ^ (((sb >> 9) & 1) << 5); R = (st >> 1) * 16 + swz / 64; C = (st & 1) * 32 + (swz % 64) / 2; }
__host__ __device__ __forceinline__ int perm32(int rho) { const int n = rho >> 4, i = rho & 15; return 8 * (i >> 2) + 4 * n + (i & 3); }

struct Unit { int pm, pn, kind; };
struct Gemm { const bf16_t* A; const bf16_t* Bt; int M, N, K; int lda, ldb; };

struct StaticOrder {
    static constexpr bool VAR_K = false;
    int nM, nN, nwg, G, c;
    __device__ void init(int M, int N, int G_, int c_) { nM = M / BM; nN = N / BM; nwg = nM * nN; G = G_; c = c_; }
    __device__ bool next(int i, Unit& u) const {
        const long L = (long)i * G + c; if (L >= nwg) return false;
        int wgid = (int)L; { const int q = nwg / NXCD, r = nwg % NXCD, xcd = wgid % NXCD, off = wgid / NXCD; wgid = (xcd < r ? xcd * (q + 1) : r * (q + 1) + (xcd - r) * q) + off; }
        const int nig = WGM * nN, gid = wgid / nig, fm = gid * WGM, gsz = (nM - fm) < WGM ? (nM - fm) : WGM;
        u.pm = fm + ((wgid % nig) % gsz); u.pn = (wgid % nig) / gsz; u.kind = 0; return true;
    }
    __device__ __forceinline__ void a_ready(const Unit&) const {}
    __device__ __forceinline__ void done(const Unit&) const {}
    static __device__ __forceinline__ bool keep_acc(const Unit&) { return false; }
};
struct InOrder {
    static constexpr bool VAR_K = false;
    int c;
    __device__ __forceinline__ bool next(int i, Unit& u) const {
        const int x = c & 7, k = c >> 3; u.kind = 0;
        if (k < 16) { if (i >= 4) return false; u.pm = 4 * x + (k & 3); u.pn = 20 + 4 * (k >> 2) + i; return true; }
        const int kk = k - 16; if (i >= 5) return false;
        u.pm = 4 * x + (kk & 3); u.pn = i < 3 ? 3 * (kk >> 2) + i : 12 + 2 * (kk >> 2) + (i - 3); return true;
    }
    __device__ __forceinline__ void a_ready(const Unit&) const {}
    __device__ __forceinline__ void done(const Unit&) const {}
    static __device__ __forceinline__ bool keep_acc(const Unit&) { return false; }
};
struct PairOrder : StaticOrder {
    int a_off, b_off;
    __device__ bool next(int i, Unit& u) const { if (!StaticOrder::next(i >> 1, u)) return false; u.kind = i & 1; if (u.kind) { u.pm += a_off; u.pn += b_off; } return true; }
    static __device__ __forceinline__ bool keep_acc(const Unit& u) { return u.kind == 0; }
};
struct GroupOrder {
    static constexpr bool VAR_K = false;
    int np[8], pb[8]; int ncol, total, G, c;
    __device__ __forceinline__ void init(const unsigned* cnt, int ncol_, int G_, int c_) {
        int acc = 0;
#pragma unroll
        for (int e = 0; e < 8; ++e) { const int n = cnt ? (int)((__builtin_amdgcn_readfirstlane(__hip_atomic_load(cnt + 64 * e, __ATOMIC_RELAXED, __HIP_MEMORY_SCOPE_AGENT)) + 255u) >> 8) : (e == 0 ? NTOK / 256 : 0); np[e] = n; pb[e] = acc; acc += n; }
        ncol = ncol_; total = acc * ncol_; G = G_; c = c_;
    }
    __device__ __forceinline__ bool next(int i, Unit& u) const {
        const long L = (long)i * G + c; if (L >= total) return false;
        int wgid = (int)L; { const int q = total / NXCD, r = total % NXCD, xcd = wgid % NXCD, off = wgid / NXCD; wgid = (xcd < r ? xcd * (q + 1) : r * (q + 1) + (xcd - r) * q) + off; }
        int local = wgid, npe = 1, pbe = 0, ee = 0; bool found = false;
#pragma unroll
        for (int k = 0; k < 8; ++k) { const int n = np[k] * ncol; if (!found) { if (local < n) { found = true; npe = np[k]; pbe = pb[k]; ee = k; } else local -= n; } }
        const int j = local / npe, p = local - j * npe;
        u.pm = pbe + p; u.pn = ee * ncol + j; u.kind = 0; return true;
    }
    __device__ __forceinline__ void a_ready(const Unit&) const {}
    __device__ __forceinline__ void done(const Unit&) const {}
    static __device__ __forceinline__ bool keep_acc(const Unit&) { return false; }
};

__device__ __forceinline__ int moe_split_r(int P, int G) { return (G == 256 && P > 64) ? P - 64 : 0; }
template <int KT> struct DownOrderT {
    static constexpr bool VAR_K = true;
    static constexpr int ktiles = KT;
    int npf[8], npa[8], pb[8]; int nfull, total, psplit0, G, c;
    __device__ __forceinline__ void init(const unsigned* cnt, int G_, int c_) {
        int acc = 0;
#pragma unroll
        for (int e = 0; e < 8; ++e) { const int n = cnt ? (int)((__builtin_amdgcn_readfirstlane(__hip_atomic_load(cnt + 64 * e, __ATOMIC_RELAXED, __HIP_MEMORY_SCOPE_AGENT)) + 255u) >> 8) : (e == 0 ? NTOK / 256 : 0); npa[e] = n; pb[e] = acc; acc += n; }
        const int r = cnt ? moe_split_r(acc, G_) : 0; psplit0 = acc - r;
#pragma unroll
        for (int e = 0; e < 8; ++e) { int f = psplit0 - pb[e]; f = f < 0 ? 0 : f; npf[e] = f < npa[e] ? f : npa[e]; }
        nfull = psplit0 * 8; total = nfull + r * 32; G = G_; c = c_;
    }
    __device__ __forceinline__ bool next(int i, Unit& u) const {
        const long L = (long)i * G + c; if (L >= total) return false;
        if (L < nfull) {
            int wgid = (int)L; { const int q = nfull / NXCD, r = nfull % NXCD, xcd = wgid % NXCD, off = wgid / NXCD; wgid = (xcd < r ? xcd * (q + 1) : r * (q + 1) + (xcd - r) * q) + off; }
            int local = wgid, npe = 1, pbe = 0, ee = 0; bool found = false;
#pragma unroll
            for (int k = 0; k < 8; ++k) { const int n = npf[k] * 8; if (!found) { if (local < n) { found = true; npe = npf[k]; pbe = pb[k]; ee = k; } else local -= n; } }
            const int j = local / npe, p = local - j * npe;
            u.pm = pbe + p; u.pn = ee * 8 + j; u.kind = 0;
        } else {
            const int q = (int)L - nfull, panel = psplit0 + (q >> 5), rem = q & 31; int ee = 0;
#pragma unroll
            for (int k = 0; k < 8; ++k) if (panel >= pb[k] && panel < pb[k] + npa[k]) ee = k;
            const int sl = rem & 3;
            u.pm = panel; u.pn = ee * 8 + (rem >> 2); u.kind = 4 + sl;
        }
        return true;
    }
    static __device__ __forceinline__ int nt_of(const Unit& u) { return u.kind < 4 ? KT : (KT == 88 ? 22 : 12 - (u.kind & 2)); }
    static __device__ __forceinline__ int koff_of(const Unit& u) { const int sl = u.kind & 3; return u.kind < 4 ? 0 : BK * (KT == 88 ? 22 * sl : 12 * sl - (sl == 3 ? 2 : 0)); }
    __device__ __forceinline__ void a_ready(const Unit&) const {}
    __device__ __forceinline__ void done(const Unit&) const {}
    static __device__ __forceinline__ bool keep_acc(const Unit&) { return false; }
};


struct EpiIn {
    static constexpr bool PERM = true, AFTER_DRAIN = false, LDS_SCALES = true;
    __device__ __forceinline__ void scale_src(const Unit& u, const GAS float*& rp, const GAS float*& cp) const { rp = sa + u.pm * BM; cp = sb + u.pn * BM; }
    const GAS float* sa; const GAS float* sb;
    GAS bf16_t* qkvuv; GAS bf16_t* gab; GAS float* ksum; GAS f32x2* vgst;
#define EPIN_V(ai, bj, m, n) ((f32x4){(float)acc[ai][bj][m][n][0], (float)acc[ai][bj][m][n][1], (float)acc[ai][bj][m][n][2], (float)acc[ai][bj][m][n][3]} * sbv[bj][n] * rs[ai][m])
    static __device__ __forceinline__ unsigned q8x4(const f32x4 x) {
        unsigned b[4];
#pragma unroll
        for (int j = 0; j < 4; ++j) { const unsigned t = __float_as_uint(__builtin_fmaf(x[j], 255.0f, 8388608.0f)); b[j] = t > 0x4B000001u ? t : 0x4B000001u; }
        return __builtin_amdgcn_perm(b[1], b[0], 0x0c0c0400u) | (__builtin_amdgcn_perm(b[3], b[2], 0x0c0c0400u) << 16);
    }
    template <int ACT> __device__ __forceinline__ void body(const i32x4 (&acc)[2][2][4][2], GAS bf16_t* base, int ldc, int row0, int col0, const f32x4 (&sbv)[2][2], const float (&rs)[2][4], GAS f32x2* vg) const {
#pragma unroll
        for (int ai = 0; ai < 2; ++ai)
#pragma unroll
            for (int m = 0; m < 4; ++m) { GAS bf16_t* rowp = base + (size_t)(row0 + ai * HALF + m * 16) * ldc + col0;
                float st1 = 0.f, st2 = 0.f;
#pragma unroll
                for (int bj = 0; bj < 2; ++bj) { f32x4 v[2];
#pragma unroll
                    for (int n = 0; n < 2; ++n) { f32x4 x;
#pragma unroll
                        for (int j = 0; j < 4; ++j) { float t; asm volatile("v_cvt_f32_i32 %0, %1" : "=v"(t) : "v"(acc[ai][bj][m][n][j])); x[j] = t * sbv[bj][n][j] * rs[ai][m]; }
                        if (ACT == 2) {
#pragma unroll
                            for (int j = 0; j < 4; ++j) x[j] = __builtin_amdgcn_rcpf(1.0f + __builtin_amdgcn_exp2f(x[j])); }
                        else if (ACT == 1 || ACT == 3) {
#pragma unroll
                            for (int j = 0; j < 4; ++j) { const float xx = x[j]; const float p = __builtin_fmaf(xx * xx, -0.10294324f, -2.30220820f); x[j] = xx * __builtin_amdgcn_rcpf(1.0f + __builtin_amdgcn_exp2f(xx * p)); }
                            if (ACT == 3) {
#pragma unroll
                                for (int j = 0; j < 4; ++j) { st1 += x[j]; st2 = __builtin_fmaf(x[j], x[j], st2); } } }
                        v[n] = x; }
                    if (ACT == 2) { u32x2 w; w.x = q8x4(v[0]); w.y = q8x4(v[1]); *(GAS u32x2*)((GAS unsigned char*)base + (size_t)(row0 + ai * HALF + m * 16) * ldc + col0 + bj * HALF) = w; }
                    else { u32x4 w; w.x = cvt_pk_bf16(v[0][0], v[0][1]); w.y = cvt_pk_bf16(v[0][2], v[0][3]); w.z = cvt_pk_bf16(v[1][0], v[1][1]); w.w = cvt_pk_bf16(v[1][2], v[1][3]);
                        *(GAS u32x4*)(rowp + bj * HALF) = w; } }
                if (ACT == 3) { st1 += __shfl_xor(st1, 16); st1 += __shfl_xor(st1, 32); st2 += __shfl_xor(st2, 16); st2 += __shfl_xor(st2, 32);
                    if ((lane_id() & 48) == 0) vg[(size_t)(row0 + ai * HALF + m * 16) * 16] = (f32x2){st1, st2}; }
                __builtin_amdgcn_sched_barrier(0); }
    }
    __device__ __forceinline__ void operator()(const i32x4 (&acc)[2][2][4][2], const Unit& u, int wr, int wc, int fr, int fq, const LAS float* scl) const {
        const int pn = u.pn; GAS bf16_t* base; int ldc, colt;
        if (pn < 20) { base = qkvuv + (size_t)(pn >> 2) * ((size_t)NTOK * 1024); ldc = 1024; colt = (pn & 3) * 256; }
        else { const int q = pn - 20; base = (GAS bf16_t*)((GAS unsigned char*)gab + (size_t)(q >> 3) * ((size_t)NTOK * 2048)); ldc = 2048; colt = (q & 7) * 256; }
        const int row0 = u.pm * BM + wr * 64 + fr, col0 = colt + wc * 32 + 8 * fq;
        f32x4 sbv[2][2]; { const LAS float* sbp = scl + 256 + wc * 32 + 8 * fq;
#pragma unroll
            for (int bj = 0; bj < 2; ++bj)
#pragma unroll
                for (int n = 0; n < 2; ++n) sbv[bj][n] = *(const LAS f32x4*)(sbp + bj * HALF + 4 * n); }
        float rs[2][4];
#pragma unroll
        for (int ai = 0; ai < 2; ++ai)
#pragma unroll
            for (int m = 0; m < 4; ++m) rs[ai][m] = scl[wr * 64 + fr + ai * HALF + m * 16];
        if (pn >= 20) {
#pragma unroll
            for (int bj = 0; bj < 2; ++bj)
#pragma unroll
                for (int n = 0; n < 2; ++n) sbv[bj][n] *= -1.4426950408889634f;
            body<2>(acc, base, ldc, row0, col0, sbv, rs, nullptr); }
        else if (pn >= 16) body<3>(acc, base, ldc, row0, col0, sbv, rs, vgst + (pn - 16) * 4 + wc);
        else if (pn >= 12) body<1>(acc, base, ldc, row0, col0, sbv, rs, nullptr);
        else {
            if (pn >= 4 && pn < 8) {
#pragma unroll
                for (int bj = 0; bj < 2; ++bj)
#pragma unroll
                    for (int n = 0; n < 2; ++n) { f32x4 sv = (f32x4){0.f, 0.f, 0.f, 0.f};
#pragma unroll
                        for (int ai = 0; ai < 2; ++ai)
#pragma unroll
                            for (int m = 0; m < 4; ++m) {
#pragma unroll
                                for (int j = 0; j < 4; ++j) { float t; asm volatile("v_cvt_f32_i32 %0, %1" : "=v"(t) : "v"(acc[ai][bj][m][n][j])); sv[j] = __builtin_fmaf(t, rs[ai][m], sv[j]); } }
                        sv *= sbv[bj][n];
#pragma unroll
                        for (int j = 0; j < 4; ++j) { float t = sv[j]; t += __shfl_xor(t, 1); t += __shfl_xor(t, 2); t += __shfl_xor(t, 4); t += __shfl_xor(t, 8); sv[j] = t; }
                        if (fr == 0) *(GAS f32x4*)(ksum + ((size_t)u.pm * 2 + wr) * 1024 + col0 + bj * HALF + 4 * n) = sv; } }
            body<0>(acc, base, ldc, row0, col0, sbv, rs, nullptr); }
    }
};
#undef EPIN_V
struct EpiMrg {
    static constexpr bool PERM = true, AFTER_DRAIN = false, LDS_SCALES = false;
    const GAS unsigned char* ga; const GAS unsigned char* gb; GAS bf16_t* mrg;
    __device__ __forceinline__ void operator()(f32x4 (&acc)[2][2][4][2], const Unit& u, int wr, int wc, int fr, int fq) const {
        const int row0 = (u.pm & 31) * BM + wr * 64 + fr, col0 = (u.pn & 7) * BM + wc * 32 + 8 * fq;
#pragma unroll
        for (int ai = 0; ai < 2; ++ai)
#pragma unroll
            for (int m = 0; m < 4; ++m) { const size_t off = (size_t)(row0 + ai * HALF + m * 16) * DM + col0;
#pragma unroll
                for (int bj = 0; bj < 2; ++bj) { const size_t o = off + bj * HALF; const u32x2 g = *(const GAS u32x2*)(gb + o);
                    const f32x4 g0 = (f32x4){(float)((g.x >> 0) & 0xffu), (float)((g.x >> 8) & 0xffu), (float)((g.x >> 16) & 0xffu), (float)((g.x >> 24) & 0xffu)};
                    const f32x4 g1 = (f32x4){(float)((g.y >> 0) & 0xffu), (float)((g.y >> 8) & 0xffu), (float)((g.y >> 16) & 0xffu), (float)((g.y >> 24) & 0xffu)};
                    if (u.kind == 0) { const u32x2 a = *(const GAS u32x2*)(ga + o);
                        const f32x4 a0 = (f32x4){(float)((a.x >> 0) & 0xffu), (float)((a.x >> 8) & 0xffu), (float)((a.x >> 16) & 0xffu), (float)((a.x >> 24) & 0xffu)};
                        const f32x4 a1 = (f32x4){(float)((a.y >> 0) & 0xffu), (float)((a.y >> 8) & 0xffu), (float)((a.y >> 16) & 0xffu), (float)((a.y >> 24) & 0xffu)};
#pragma unroll
                        for (int j = 0; j < 4; ++j) { acc[ai][bj][m][0][j] *= a0[j] * __builtin_amdgcn_rcpf(g0[j]); acc[ai][bj][m][1][j] *= a1[j] * __builtin_amdgcn_rcpf(g1[j]); } }
                    else { const f32x4 r0 = acc[ai][bj][m][0] * (g0 * (1.0f / 255.0f)), r1 = acc[ai][bj][m][1] * (g1 * (1.0f / 255.0f));
                        u32x4 w; w.x = cvt_pk_bf16(r0[0], r0[1]); w.y = cvt_pk_bf16(r0[2], r0[3]); w.z = cvt_pk_bf16(r1[0], r1[1]); w.w = cvt_pk_bf16(r1[2], r1[3]);
                        *(GAS u32x4*)(mrg + o) = w; } } }
    }
};
template <bool RES_F32> struct EpiRes {
    static constexpr bool PERM = true, AFTER_DRAIN = false, LDS_SCALES = false;
    const GAS float* resf; const GAS bf16_t* resb; GAS bf16_t* out;
    __device__ __forceinline__ void operator()(const f32x4 (&acc)[2][2][4][2], const Unit& u, int wr, int wc, int fr, int fq) const {
        const int row0 = u.pm * BM + wr * 64 + fr, col0 = (u.pn & 7) * BM + wc * 32 + 8 * fq;
#pragma unroll
        for (int ai = 0; ai < 2; ++ai)
#pragma unroll
            for (int m = 0; m < 4; ++m) { const size_t off = (size_t)(row0 + ai * HALF + m * 16) * DM + col0;
#pragma unroll
                for (int bj = 0; bj < 2; ++bj) { const size_t o = off + bj * HALF; f32x4 r0, r1;
                    if (RES_F32) { r0 = *(const GAS f32x4*)(resf + o); r1 = *(const GAS f32x4*)(resf + o + 4); }
                    else { const u32x4 w = *(const GAS u32x4*)(resb + o); r0 = (f32x4){bflo(w.x), bfhi(w.x), bflo(w.y), bfhi(w.y)}; r1 = (f32x4){bflo(w.z), bfhi(w.z), bflo(w.w), bfhi(w.w)}; }
                    r0 += acc[ai][bj][m][0]; r1 += acc[ai][bj][m][1];
                    u32x4 w; w.x = cvt_pk_bf16(r0[0], r0[1]); w.y = cvt_pk_bf16(r0[2], r0[3]); w.z = cvt_pk_bf16(r1[0], r1[1]); w.w = cvt_pk_bf16(r1[2], r1[3]);
                    *(GAS u32x4*)(out + o) = w; } }
    }
};
struct EpiRes8 {
    static constexpr bool PERM = true, AFTER_DRAIN = false, LDS_SCALES = true;
    __device__ __forceinline__ void scale_src(const Unit& u, const GAS float*& rp, const GAS float*& cp) const { rp = sa + u.pm * BM; cp = sb + u.pn * BM; }
    const GAS float* sa; const GAS float* sb; GAS bf16_t* yp; int split_row0; GAS bf16_t* yb;
    __device__ __forceinline__ void operator()(const i32x4 (&acc)[2][2][4][2], const Unit& u, int wr, int wc, int fr, int fq, const LAS float* scl) const {
        const int row0 = u.pm * BM + wr * 64 + fr, col0 = (u.pn & 7) * BM + wc * 32 + 8 * fq;
        f32x4 sbv[2][2]; { const LAS float* sbp = scl + 256 + wc * 32 + 8 * fq;
#pragma unroll
            for (int bj = 0; bj < 2; ++bj)
#pragma unroll
                for (int n = 0; n < 2; ++n) sbv[bj][n] = *(const LAS f32x4*)(sbp + bj * HALF + 4 * n); }
        const int sl = u.kind & 3;
#pragma unroll
        for (int ai = 0; ai < 2; ++ai)
#pragma unroll
            for (int m = 0; m < 4; ++m) { const int r = row0 + ai * HALF + m * 16; const float s = scl[wr * 64 + fr + ai * HALF + m * 16];
                GAS bf16_t* dst = sl == 0 ? yb + (size_t)r * DM + col0 : yp + ((size_t)(sl - 1) * 2048 + (size_t)(r - split_row0)) * DM + col0;
#pragma unroll
                for (int bj = 0; bj < 2; ++bj) { f32x4 v[2];
#pragma unroll
                    for (int n = 0; n < 2; ++n) v[n] = (f32x4){(float)acc[ai][bj][m][n][0], (float)acc[ai][bj][m][n][1], (float)acc[ai][bj][m][n][2], (float)acc[ai][bj][m][n][3]} * sbv[bj][n] * s;
                    u32x4 w; w.x = cvt_pk_bf16(v[0][0], v[0][1]); w.y = cvt_pk_bf16(v[0][2], v[0][3]); w.z = cvt_pk_bf16(v[1][0], v[1][1]); w.w = cvt_pk_bf16(v[1][2], v[1][3]);
                    *(GAS u32x4*)(dst + bj * HALF) = w; } }
    }
};
struct EpiResX8 {
    static constexpr bool PERM = true, AFTER_DRAIN = false, LDS_SCALES = true;
    __device__ __forceinline__ void scale_src(const Unit& u, const GAS float*& rp, const GAS float*& cp) const { rp = sa + u.pm * BM; cp = sb + u.pn * BM; }
    const GAS float* sa; const GAS float* sb; GAS bf16_t* x;
    __device__ __forceinline__ void operator()(const i32x4 (&acc)[2][2][4][2], const Unit& u, int wr, int wc, int fr, int fq, const LAS float* scl) const {
        const int row0 = u.pm * BM + wr * 64 + fr, col0 = (u.pn & 7) * BM + wc * 32 + 8 * fq;
        f32x4 sbv[2][2]; { const LAS float* sbp = scl + 256 + wc * 32 + 8 * fq;
#pragma unroll
            for (int bj = 0; bj < 2; ++bj)
#pragma unroll
                for (int n = 0; n < 2; ++n) sbv[bj][n] = *(const LAS f32x4*)(sbp + bj * HALF + 4 * n); }
#pragma unroll
        for (int ai = 0; ai < 2; ++ai)
#pragma unroll
            for (int m = 0; m < 4; ++m) { const int r = row0 + ai * HALF + m * 16; const float s = scl[wr * 64 + fr + ai * HALF + m * 16]; GAS bf16_t* xp = x + (size_t)r * DM + col0;
#pragma unroll
                for (int bj = 0; bj < 2; ++bj) { const u32x4 w0 = *(const GAS u32x4*)(xp + bj * HALF);
                    f32x4 r0 = (f32x4){bflo(w0.x), bfhi(w0.x), bflo(w0.y), bfhi(w0.y)}, r1 = (f32x4){bflo(w0.z), bfhi(w0.z), bflo(w0.w), bfhi(w0.w)};
                    r0 += (f32x4){(float)acc[ai][bj][m][0][0], (float)acc[ai][bj][m][0][1], (float)acc[ai][bj][m][0][2], (float)acc[ai][bj][m][0][3]} * sbv[bj][0] * s;
                    r1 += (f32x4){(float)acc[ai][bj][m][1][0], (float)acc[ai][bj][m][1][1], (float)acc[ai][bj][m][1][2], (float)acc[ai][bj][m][1][3]} * sbv[bj][1] * s;
                    u32x4 w; w.x = cvt_pk_bf16(r0[0], r0[1]); w.y = cvt_pk_bf16(r0[2], r0[3]); w.z = cvt_pk_bf16(r1[0], r1[1]); w.w = cvt_pk_bf16(r1[2], r1[3]);
                    *(GAS u32x4*)(xp + bj * HALF) = w; } }
    }
};
struct EpiGU {
    static constexpr bool PERM = true, AFTER_DRAIN = false, LDS_SCALES = false;
    GAS bf16_t* act; int ncol;
    __device__ __forceinline__ void operator()(const f32x4 (&acc)[2][2][4][2], const Unit& u, int wr, int wc, int fr, int fq) const {
        const int jt = u.pn % ncol; const int row0 = u.pm * BM + wr * 64 + fr, col0 = jt * 128 + wc * 32 + 8 * fq;
#pragma unroll
        for (int ai = 0; ai < 2; ++ai)
#pragma unroll
            for (int m = 0; m < 4; ++m) { GAS bf16_t* rowp = act + (size_t)(row0 + ai * HALF + m * 16) * FF + col0;
                f32x4 v0, v1;
#pragma unroll
                for (int j = 0; j < 4; ++j) { v0[j] = silu_f(acc[ai][0][m][0][j]) * acc[ai][1][m][0][j]; v1[j] = silu_f(acc[ai][0][m][1][j]) * acc[ai][1][m][1][j]; }
                u32x4 w; w.x = cvt_pk_bf16(v0[0], v0[1]); w.y = cvt_pk_bf16(v0[2], v0[3]); w.z = cvt_pk_bf16(v1[0], v1[1]); w.w = cvt_pk_bf16(v1[2], v1[3]);
                *(GAS u32x4*)rowp = w; }
    }
};

struct EpiGU8 {
    static constexpr bool PERM = true, AFTER_DRAIN = false, LDS_SCALES = true;
    __device__ __forceinline__ void scale_src(const Unit& u, const GAS float*& rp, const GAS float*& cp) const { rp = sa + u.pm * BM; cp = sb + u.pn * BM; }
    GAS bf16_t* act; int ncol; const GAS float* sa; const GAS float* sb;
    __device__ __forceinline__ void operator()(const i32x4 (&acc)[2][2][4][2], const Unit& u, int wr, int wc, int fr, int fq, const LAS float* scl) const {
        const int jt = u.pn % ncol; const int row0 = u.pm * BM + wr * 64 + fr, col0 = jt * 128 + wc * 32 + 8 * fq;
        const LAS float* sbp = scl + 256 + wc * 32 + 8 * fq;
        const f32x4 sg0 = *(const LAS f32x4*)sbp * -1.4426950408889634f, sg1 = *(const LAS f32x4*)(sbp + 4) * -1.4426950408889634f, su0 = *(const LAS f32x4*)(sbp + HALF) * -0.6931471805599453f, su1 = *(const LAS f32x4*)(sbp + HALF + 4) * -0.6931471805599453f;
#pragma unroll
        for (int ai = 0; ai < 2; ++ai)
#pragma unroll
            for (int m = 0; m < 4; ++m) { const int r = row0 + ai * HALF + m * 16; GAS bf16_t* rowp = act + (size_t)r * FF + col0; const float ra = scl[wr * 64 + fr + ai * HALF + m * 16];
                f32x4 v0, v1;
#pragma unroll
                for (int j = 0; j < 4; ++j) { const float g0 = (float)acc[ai][0][m][0][j] * (ra * sg0[j]), g1 = (float)acc[ai][0][m][1][j] * (ra * sg1[j]);
                    v0[j] = g0 * __builtin_amdgcn_rcpf(1.0f + __builtin_amdgcn_exp2f(g0)) * ((float)acc[ai][1][m][0][j] * (ra * su0[j]));
                    v1[j] = g1 * __builtin_amdgcn_rcpf(1.0f + __builtin_amdgcn_exp2f(g1)) * ((float)acc[ai][1][m][1][j] * (ra * su1[j])); }
                u32x4 w; w.x = cvt_pk_bf16(v0[0], v0[1]); w.y = cvt_pk_bf16(v0[2], v0[3]); w.z = cvt_pk_bf16(v1[0], v1[1]); w.w = cvt_pk_bf16(v1[2], v1[3]);
                *(GAS u32x4*)rowp = w; }
    }
};

template <bool I8> struct AccT { typedef f32x4 t; };
template <> struct AccT<true> { typedef i32x4 t; };
__device__ __forceinline__ f32x4 mma_op(bf16x8 b, bf16x8 a, f32x4 c) { return __builtin_amdgcn_mfma_f32_16x16x32_bf16(b, a, c, 0, 0, 0); }
__device__ __forceinline__ i32x4 mma_op(bf16x8 b, bf16x8 a, i32x4 c) { return __builtin_amdgcn_mfma_i32_16x16x64_i8(__builtin_bit_cast(i32x4, b), __builtin_bit_cast(i32x4, a), c, 0, 0, 0); }
template <class Epi, class Sched, bool ALIGN_EPI = false, bool SP2 = false, bool I8 = false>
__device__ __forceinline__ void gemm_phase(LAS unsigned char* lds, const Gemm g, const Sched& S, const Epi& E, int tid) {
    asm volatile("" : "+v"(tid));
    const int wid = __builtin_amdgcn_readfirstlane(tid >> 6), lane = tid & 63, wr = wid >> 2, wc = wid & 3, fr = lane & 15, fq = lane >> 4;
    const int K = g.K, nt = K / BK, lda = g.lda ? g.lda : K, ldb = g.ldb ? g.ldb : K;
    unsigned voffA[2], voffB[2];
#pragma unroll
    for (int i = 0; i < 2; ++i) { int R, C; stage_rc(tid * 16 + i * 8192, R, C); const int Rb = Epi::PERM ? ((R & ~31) + perm32(R & 31)) : R;
        voffA[i] = (unsigned)(R * lda + C) * 2u; voffB[i] = (unsigned)(Rb * ldb + C) * 2u; }
    const size_t kstep = (size_t)(BK * 2);
    const size_t hstep = (size_t)HALF * lda * 2, hstepB = (size_t)HALF * ldb * 2;
    const size_t tstep = 2 * hstep, tstepB = 2 * hstepB;
    const unsigned ldsw = (unsigned)wid * 1024u;
    const int aoff = lds_byte(wr * 64 + fr, fq * 8), boff = lds_byte(wc * 32 + fr, fq * 8);
#define PG8_SA(b, h) (((b) * 2 + (h)) * HTB)
#define PG8_SB(b, h) ((4 + (b) * 2 + (h)) * HTB)
#define PG8_STAGE(bufoff, gbase, voff) do { _Pragma("unroll") for (int _i = 0; _i < 2; ++_i) \
        __builtin_amdgcn_global_load_lds((const unsigned*)((const char*)(gbase) + (voff)[_i]), (LAS unsigned*)(lds + (bufoff) + ldsw + _i * 8192), 16, 0, 0); } while (0)
#define PG8_LDA(dst, b, h) do { _Pragma("unroll") for (int m = 0; m < 4; ++m) _Pragma("unroll") for (int k = 0; k < 2; ++k) dst[m][k] = *(const LAS bf16x8*)(lds + PG8_SA(b, h) + aoff + m * 2048 + k * 1024); } while (0)
#define PG8_LDB(dst, b, h) do { _Pragma("unroll") for (int n = 0; n < 2; ++n) _Pragma("unroll") for (int k = 0; k < 2; ++k) dst[n][k] = *(const LAS bf16x8*)(lds + PG8_SB(b, h) + boff + n * 2048 + k * 1024); } while (0)
#define PG8_MMA(ai, bj, At, Bt) do { __builtin_amdgcn_s_setprio(1); _Pragma("unroll") for (int m = 0; m < 4; ++m) _Pragma("unroll") for (int n = 0; n < 2; ++n) _Pragma("unroll") for (int k = 0; k < 2; ++k) \
        acc[ai][bj][m][n] = mma_op(Bt[n][k], At[m][k], acc[ai][bj][m][n]); __builtin_amdgcn_s_setprio(0); } while (0)
#define PG8_WAIT_V(n) asm volatile("s_waitcnt vmcnt(" #n ")" ::: "memory")
#define PG8_WAIT_L(n) asm volatile("s_waitcnt lgkmcnt(" #n ")" ::: "memory")
#define PG8_BAR __builtin_amdgcn_s_barrier()
#define PG8_SCHED __builtin_amdgcn_sched_barrier(0)
    Unit cur, nxt; int ui = 0;
    if (!S.next(0, cur)) return;
#define PG8_SCALES(uu, par) do { if constexpr (Epi::LDS_SCALES) { const GAS float* rp_; const GAS float* cp_; E.scale_src(uu, rp_, cp_); \
        __builtin_amdgcn_global_load_lds((const unsigned*)((wid < 4 ? rp_ : cp_ - 256) + wid * 64 + lane), (LAS unsigned*)(lds + SCL_OFF + (par) * 2048 + wid * 256), 4, 0, 0); } } while (0)
    typedef typename AccT<I8>::t acc_t;
    acc_t acc[2][2][4][2];
#pragma unroll
    for (int a = 0; a < 2; ++a)
#pragma unroll
        for (int b = 0; b < 2; ++b)
#pragma unroll
            for (int m = 0; m < 4; ++m)
#pragma unroll
                for (int n = 0; n < 2; ++n) acc[a][b][m][n] = (acc_t){0, 0, 0, 0};
    bf16x8 At[4][2], B0[2][2], B1[2][2];
    const char* cA = (const char*)g.A + (size_t)cur.pm * tstep; const char* cB = (const char*)g.Bt + (size_t)cur.pn * tstepB;
    int unt = nt;
    if constexpr (Sched::VAR_K) { const int ko = Sched::koff_of(cur); cA += (size_t)ko * 2; cB += (size_t)ko * 2; unt = Sched::nt_of(cur); }
    S.a_ready(cur);
    PG8_SCALES(cur, 0);
    if constexpr (SP2) {
        PG8_STAGE(PG8_SB(0, 0), cB, voffB); PG8_STAGE(PG8_SB(0, 1), cB + hstepB, voffB); PG8_STAGE(PG8_SA(0, 0), cA, voffA); PG8_STAGE(PG8_SA(0, 1), cA + hstep, voffA);
        if (wr == 1) PG8_BAR;
        PG8_WAIT_V(2); PG8_BAR;
        PG8_STAGE(PG8_SB(1, 0), cB + kstep, voffB); PG8_STAGE(PG8_SA(1, 0), cA + kstep, voffA); PG8_STAGE(PG8_SB(1, 1), cB + hstepB + kstep, voffB);
        PG8_WAIT_V(6); PG8_BAR;
    } else {
        PG8_STAGE(PG8_SB(0, 0), cB, voffB); PG8_STAGE(PG8_SA(0, 0), cA, voffA); PG8_STAGE(PG8_SB(0, 1), cB + hstepB, voffB); PG8_STAGE(PG8_SA(0, 1), cA + hstep, voffA);
        if (wr == 1) PG8_BAR;
        PG8_WAIT_V(4); PG8_BAR;
        PG8_STAGE(PG8_SB(1, 0), cB + kstep, voffB); PG8_STAGE(PG8_SA(1, 0), cA + kstep, voffA); PG8_STAGE(PG8_SB(1, 1), cB + hstepB + kstep, voffB);
        PG8_WAIT_V(6); PG8_BAR;
    }
    for (;;) {
        const bool has_next = S.next(ui + 1, nxt);
        const char* nA = has_next ? (const char*)g.A + (size_t)nxt.pm * tstep : cA; const char* nB = has_next ? (const char*)g.Bt + (size_t)nxt.pn * tstepB : cB;
        if constexpr (Sched::VAR_K) { if (has_next) { const int ko = Sched::koff_of(nxt); nA += (size_t)ko * 2; nB += (size_t)ko * 2; } }
        for (int t = 0; t < unt; t += 2) {
            const bool last = (t == unt - 2);
            const char* a1 = cA + (size_t)(t + 1) * kstep;
            const char* a2 = last ? nA : cA + (size_t)(t + 2) * kstep; const char* b2 = last ? nB : cB + (size_t)(t + 2) * kstep;
            const char* a3 = a2 + kstep; const char* b3 = b2 + kstep;
            if (last && has_next) S.a_ready(nxt);
            if constexpr (SP2) {
            PG8_LDB(B0, 0, 0); PG8_LDB(B1, 0, 1); PG8_SCHED; PG8_LDA(At, 0, 0); PG8_STAGE(PG8_SA(1, 1), a1 + hstep, voffA);
            PG8_WAIT_V(8); PG8_WAIT_L(0); PG8_BAR; PG8_MMA(0, 0, At, B0); PG8_MMA(0, 1, At, B1); PG8_BAR; PG8_SCHED;
            PG8_LDA(At, 0, 1); PG8_STAGE(PG8_SB(0, 0), b2, voffB); PG8_STAGE(PG8_SB(0, 1), b2 + hstepB, voffB); PG8_STAGE(PG8_SA(0, 0), a2, voffA);
            PG8_WAIT_V(8); PG8_WAIT_L(0); PG8_BAR; PG8_MMA(1, 0, At, B0); PG8_MMA(1, 1, At, B1); PG8_BAR; PG8_SCHED;
            PG8_LDB(B0, 1, 0); PG8_LDB(B1, 1, 1); PG8_SCHED; PG8_LDA(At, 1, 0); PG8_STAGE(PG8_SA(0, 1), a2 + hstep, voffA);
            PG8_WAIT_V(8); PG8_WAIT_L(0); PG8_BAR; PG8_MMA(0, 0, At, B0); PG8_MMA(0, 1, At, B1); PG8_BAR; PG8_SCHED;
            PG8_LDA(At, 1, 1); PG8_STAGE(PG8_SB(1, 0), b3, voffB); PG8_STAGE(PG8_SB(1, 1), b3 + hstepB, voffB); PG8_STAGE(PG8_SA(1, 0), a3, voffA);
            PG8_WAIT_V(8); PG8_WAIT_L(0); PG8_BAR; PG8_MMA(1, 0, At, B0); PG8_MMA(1, 1, At, B1); PG8_BAR; PG8_SCHED;
            } else {
            PG8_LDB(B0, 0, 0); PG8_SCHED; PG8_LDA(At, 0, 0); PG8_STAGE(PG8_SA(1, 1), a1 + hstep, voffA);
            PG8_WAIT_L(8); PG8_BAR; PG8_WAIT_L(0); PG8_MMA(0, 0, At, B0); PG8_BAR; PG8_SCHED;
            PG8_LDB(B1, 0, 1); PG8_STAGE(PG8_SB(0, 0), b2, voffB);
            PG8_BAR; PG8_WAIT_L(0); PG8_MMA(0, 1, At, B1); PG8_BAR;
            PG8_LDA(At, 0, 1); PG8_STAGE(PG8_SA(0, 0), a2, voffA);
            PG8_BAR; PG8_WAIT_L(0); PG8_MMA(1, 0, At, B0); PG8_BAR; PG8_SCHED;
            PG8_STAGE(PG8_SB(0, 1), b2 + hstepB, voffB);
            PG8_WAIT_V(6); PG8_BAR; PG8_MMA(1, 1, At, B1); PG8_BAR;
            PG8_LDB(B0, 1, 0); PG8_SCHED; PG8_LDA(At, 1, 0); PG8_STAGE(PG8_SA(0, 1), a2 + hstep, voffA);
            PG8_WAIT_L(8); PG8_BAR; PG8_WAIT_L(0); PG8_MMA(0, 0, At, B0); PG8_BAR; PG8_SCHED;
            PG8_LDB(B1, 1, 1); PG8_STAGE(PG8_SB(1, 0), b3, voffB);
            PG8_BAR; PG8_WAIT_L(0); PG8_MMA(0, 1, At, B1); PG8_BAR;
            PG8_LDA(At, 1, 1); PG8_STAGE(PG8_SA(1, 0), a3, voffA);
            PG8_BAR; PG8_WAIT_L(0); PG8_MMA(1, 0, At, B0); PG8_BAR; PG8_SCHED;
            PG8_STAGE(PG8_SB(1, 1), b3 + hstepB, voffB);
            PG8_WAIT_V(6); PG8_BAR; PG8_MMA(1, 1, At, B1); PG8_BAR;
            }
        }
        if constexpr (ALIGN_EPI) { if (wr == 0) PG8_BAR; }
        if constexpr (Epi::LDS_SCALES) { E(acc, cur, wr, wc, fr, fq, (const LAS float*)(lds + SCL_OFF + (ui & 1) * 2048)); S.done(cur); }
        else if constexpr (!Epi::AFTER_DRAIN) { E(acc, cur, wr, wc, fr, fq); S.done(cur); }
        if (!has_next) break;
        if (!Sched::keep_acc(cur)) {
#pragma unroll
        for (int a = 0; a < 2; ++a)
#pragma unroll
            for (int b = 0; b < 2; ++b)
#pragma unroll
                for (int m = 0; m < 4; ++m)
#pragma unroll
                    for (int n = 0; n < 2; ++n) acc[a][b][m][n] = (acc_t){0, 0, 0, 0};
        }
        cur = nxt; cA = nA; cB = nB; ++ui; if constexpr (Sched::VAR_K) unt = Sched::nt_of(cur);
        if constexpr (ALIGN_EPI) { if (wr == 1) PG8_BAR; }
        PG8_SCALES(cur, ui & 1);
    }
    PG8_WAIT_V(0);
    if constexpr (!ALIGN_EPI) { if (wr == 0) PG8_BAR; }
    PG8_BAR;
#undef PG8_SCALES
#undef PG8_SA
#undef PG8_SB
#undef PG8_STAGE
#undef PG8_LDA
#undef PG8_LDB
#undef PG8_MMA
#undef PG8_WAIT_V
#undef PG8_WAIT_L
#undef PG8_BAR
#undef PG8_SCHED
}
}

namespace att {
constexpr int D = 128, PITCH = 1024, NW = 8, QBLK = 32, KVBLK = 64, QB = NW * QBLK;
constexpr int SHM_V = KVBLK * D * 2, SHM_K = KVBLK * D * 2;
constexpr int ATT_LDS = 2 * SHM_V + 2 * SHM_K + NW * 64 * 4;
constexpr int KMEAN_OFF = ATT_LDS;
constexpr int PART_OFF = KMEAN_OFF + 4096;
constexpr float SCALE = 0.08838834764831845f;
constexpr float THR = 8.f;
constexpr int WBIG = 1 << 30;
#define KSWZ(row, colB) ((row) * 256 + ((colB) ^ (((row) & 7) << 4)))
#define SBAR() __builtin_amdgcn_sched_barrier(0)
__device__ __forceinline__ int v_st(int k, int c) { const int kk = (k & ~0xC) | ((k & 4) << 1) | ((k & 8) >> 1); return ((kk >> 3) * 4 + (c >> 5)) * 512 + ((kk & 7) * 32 + (c & 31)) * 2; }
__device__ __forceinline__ int v_rd_base(int lane) { return ((lane & 3) << 3) | (((lane >> 2) & 3) << 6) | (((lane >> 4) & 1) << 5) | (((lane >> 5) & 1) << 8); }
constexpr int v_rd_off(int d0, int ks, int half) { return d0 * 512 + ks * 4096 + half * 2048; }
__device__ __forceinline__ int crow(int r, int hi) { return (r & 3) + 8 * (r >> 2) + 4 * hi; }
__device__ __forceinline__ unsigned cvtpk(float lo, float hi) { unsigned r; asm volatile("v_cvt_pk_bf16_f32 %0, %1, %2" : "=v"(r) : "v"(lo), "v"(hi)); return r; }
__device__ __forceinline__ bf16x8 load8(const GAS bf16_t* p) { return *(const GAS bf16x8*)p; }
__device__ __forceinline__ void mask_tile(f32x16& p0, f32x16& p1, int dq, unsigned W) {
    const float NEG = -__builtin_inff();
#pragma unroll
    for (int r = 0; r < 16; ++r) {
        const int c = (r & 3) + 8 * (r >> 2);
        if ((unsigned)(dq - c) >= W) p0[r] = NEG;
        if ((unsigned)(dq - c - 32) >= W) p1[r] = NEG;
    }
}
__device__ __forceinline__ void partialSM(f32x16& p0, f32x16& p1, float& m_reg, float& mn, float& alpha) {
    float pmax = p0[0]; for (int r = 1; r < 16; ++r) pmax = fmaxf(pmax, p0[r]); for (int r = 0; r < 16; ++r) pmax = fmaxf(pmax, p1[r]);
    { auto rr = __builtin_amdgcn_permlane32_swap(__float_as_uint(pmax), __float_as_uint(pmax), false, false);
      pmax = fmaxf(__uint_as_float(rr[0]), __uint_as_float(rr[1])); }
    constexpr float C2 = 1.4426950408889634f * SCALE;
    if (__builtin_expect(__all((pmax - m_reg) * SCALE <= THR), 1)) { mn = m_reg; alpha = 1.f; }
    else { mn = fmaxf(m_reg, pmax); alpha = __builtin_amdgcn_exp2f((m_reg - mn) * C2); m_reg = mn; }
    const float mnL = -mn * C2;
    for (int r = 0; r < 16; ++r) p0[r] = fmaf(p0[r], C2, mnL); for (int r = 0; r < 16; ++r) p1[r] = fmaf(p1[r], C2, mnL);
    for (int r = 0; r < 16; ++r) p0[r] = __builtin_amdgcn_exp2f(p0[r]);
}
__device__ __forceinline__ void finishSM(f32x16& p0, f32x16& p1, float alpha, float& l_reg, bf16x8& pa0, bf16x8& pa1, bf16x8& pa2, bf16x8& pa3) {
    for (int r = 0; r < 16; ++r) p1[r] = __builtin_amdgcn_exp2f(p1[r]);
    float ps = 0; for (int r = 0; r < 16; ++r) ps += p0[r]; for (int r = 0; r < 16; ++r) ps += p1[r];
    { auto rr = __builtin_amdgcn_permlane32_swap(__float_as_uint(ps), __float_as_uint(ps), false, false);
      ps = __uint_as_float(rr[0]) + __uint_as_float(rr[1]); }
    l_reg = l_reg * alpha + ps;
#define PK4(P, B_, OUT) do { unsigned a0 = cvtpk(P[B_+0], P[B_+1]), a1 = cvtpk(P[B_+2], P[B_+3]);                          \
        unsigned b0 = cvtpk(P[B_+4], P[B_+5]), b1 = cvtpk(P[B_+6], P[B_+7]);                                             \
        auto r0 = __builtin_amdgcn_permlane32_swap(a0, b0, false, false); auto r1 = __builtin_amdgcn_permlane32_swap(a1, b1, false, false); \
        u32x4 w = {r0[0], r1[0], r0[1], r1[1]}; OUT = *reinterpret_cast<bf16x8*>(&w); } while (0)
    PK4(p0, 0, pa0); PK4(p0, 8, pa1); PK4(p1, 0, pa2); PK4(p1, 8, pa3);
#undef PK4
}
template <int KB>
__device__ __forceinline__ void qkt(f32x16& p0, f32x16& p1, const char* K_lds, int r32, int hi, const bf16x8* qr) {
    p0 = f32x16{}; p1 = f32x16{};
    const char* kb[4];
#pragma unroll
    for (int dd = 0; dd < 4; ++dd) kb[dd] = K_lds + KB * SHM_K + KSWZ(r32, (dd * 16 + hi * 8) * 2);
#pragma unroll
    for (int d0 = 0; d0 < 8; ++d0) { const char* a = kb[d0 & 3] + (d0 >> 2) * 128;
        bf16x8 b0 = *reinterpret_cast<const bf16x8*>(a);
        bf16x8 b1 = *reinterpret_cast<const bf16x8*>(a + 32 * 256);
        p0 = __builtin_amdgcn_mfma_f32_32x32x16_bf16(b0, qr[d0], p0, 0, 0, 0);
        p1 = __builtin_amdgcn_mfma_f32_32x32x16_bf16(b1, qr[d0], p1, 0, 0, 0); }
}
template <int VB>
__device__ __forceinline__ void pv_tile(f32x16* o, int vb0, bf16x8 pa0, bf16x8 pa1, bf16x8 pa2, bf16x8 pa3) {
#define TRRD(dst, off) asm volatile("ds_read_b64_tr_b16 %0, %1 offset:%2" : "=&v"(dst) : "v"(vb0), "i"(off) : "memory")
#define PV_D0(d0) do { s16x4 l0, l1, l2, l3, h0, h1, h2, h3; constexpr int b_ = VB * SHM_V + v_rd_off(d0, 0, 0); \
        TRRD(l0, b_); TRRD(h0, b_ + 2048); TRRD(l1, b_ + 4096); TRRD(h1, b_ + 6144); TRRD(l2, b_ + 8192); TRRD(h2, b_ + 10240); TRRD(l3, b_ + 12288); TRRD(h3, b_ + 14336); \
        asm volatile("s_waitcnt lgkmcnt(0)" ::: "memory"); SBAR();   \
        o[d0] = __builtin_amdgcn_mfma_f32_32x32x16_bf16(pa0, (bf16x8){l0[0], l0[1], l0[2], l0[3], h0[0], h0[1], h0[2], h0[3]}, o[d0], 0, 0, 0);   \
        o[d0] = __builtin_amdgcn_mfma_f32_32x32x16_bf16(pa1, (bf16x8){l1[0], l1[1], l1[2], l1[3], h1[0], h1[1], h1[2], h1[3]}, o[d0], 0, 0, 0);   \
        o[d0] = __builtin_amdgcn_mfma_f32_32x32x16_bf16(pa2, (bf16x8){l2[0], l2[1], l2[2], l2[3], h2[0], h2[1], h2[2], h2[3]}, o[d0], 0, 0, 0);   \
        o[d0] = __builtin_amdgcn_mfma_f32_32x32x16_bf16(pa3, (bf16x8){l3[0], l3[1], l3[2], l3[3], h3[0], h3[1], h3[2], h3[3]}, o[d0], 0, 0, 0); } while (0)
    PV_D0(0); PV_D0(1); PV_D0(2); PV_D0(3);
#undef PV_D0
#undef TRRD
}
struct BlockRef { const GAS bf16_t* Q; const GAS bf16_t* K; const GAS bf16_t* V; GAS bf16_t* O; int P0; };
struct Seam { bf16x8 qr[8]; bf16x8 st_v0, st_v1, st_k0, st_k1; };
#define ROW(p, k0, rr) ((p) + (size_t)((k0) + (rr)) * PITCH + sc)
#define VMW() asm volatile("s_waitcnt vmcnt(0)" ::: "memory")
#define VMWN(n) asm volatile("s_waitcnt vmcnt(%0)" :: "i"(n) : "memory")
#define SLOAD_H(Kp, Vp, k0) do { S.st_v0 = load8(ROW(Vp, k0, sr)); S.st_v1 = load8(ROW(Vp, k0, 32 + sr));              \
                         S.st_k0 = load8(ROW(Kp, k0, sr)); S.st_k1 = load8(ROW(Kp, k0, 32 + sr)); } while (0)
#define SWRITE_HK(bf) do { *(bf16x8*)(K_lds + (bf) * SHM_K + kws) = S.st_k0; *(bf16x8*)(K_lds + (bf) * SHM_K + kws + 32 * 256) = S.st_k1; } while (0)
#define SWRITE_HV(bf) do { *(bf16x8*)(V_lds + (bf) * SHM_V + vst0) = S.st_v0; *(bf16x8*)(V_lds + (bf) * SHM_V + vst1) = S.st_v1; } while (0)
#define SWRITE_H(bf) do { SWRITE_HV(bf); SWRITE_HK(bf); } while (0)
__device__ __forceinline__ void attn_prime(const BlockRef& cur, char* lds, Seam& S, const int tid) {
    const int wid = __builtin_amdgcn_readfirstlane(tid >> 6), lane = tid & 63, r32 = lane & 31, hi = lane >> 5;
    const int sr = tid >> 4, sc = (tid & 15) * 8, kws = KSWZ(sr, sc * 2); char* K_lds = lds + 2 * SHM_V;
    const int kb0 = 0;
    for (int d0 = 0; d0 < 8; ++d0) S.qr[d0] = load8(cur.Q + (size_t)(wid * QBLK + r32) * PITCH + d0 * 16 + hi * 8);
    SLOAD_H(cur.K, cur.V, kb0); VMW(); SWRITE_HK(0);
    __syncthreads();
}
__device__ __forceinline__ void attn_block(const BlockRef& cur, const BlockRef& nxt, char* lds, Seam& S, unsigned selmask, const int tid) {
    const int W = WBIG;
    const int wid = __builtin_amdgcn_readfirstlane(tid >> 6), lane = tid & 63, r32 = lane & 31, hi = lane >> 5;
    const int j_lo = 0;
    const int j_hi = (cur.P0 + QB - 1) / KVBLK + 1;
    const int NT = j_hi - j_lo;
    const int kbn = 0;
    const int qlo = cur.P0 + wid * QBLK, qm = qlo + r32 - 4 * hi;
    char* V_lds = lds; char* K_lds = lds + 2 * SHM_V;
    float* ws = (float*)(lds + 2 * SHM_V + 2 * SHM_K) + wid * 64; float* li_l = ws, * al_l = ws + 32;
    float m_reg = -1e30f, l_reg = 0; f32x16 o[4] = {};
    const int sr = tid >> 4, sc = (tid & 15) * 8, vst0 = v_st(sr, sc), vst1 = v_st(32 + sr, sc), kws = KSWZ(sr, sc * 2);
    const int vb0 = (int)(uintptr_t)V_lds + v_rd_base(lane);
    const GAS bf16_t* Kh = cur.K; const GAS bf16_t* Vh = cur.V;
#define RESC(a) do { if (__any((a) < 1.f)) { if (hi == 0) al_l[r32] = (a); asm volatile("s_waitcnt lgkmcnt(0)" ::: "memory");              \
                     for (int d_ = 0; d_ < 4; ++d_) for (int r = 0; r < 16; ++r) o[d_][r] *= al_l[crow(r, hi)]; } } while (0)
#define KBASE(t) ((j_lo + (t)) * KVBLK)
#define MASKT(P0_, P1_, t) do { const int kb_ = KBASE(t); if (kb_ + KVBLK - 1 > qlo) mask_tile(P0_, P1_, qm - kb_, (unsigned)W); \
        if (kb_ < cur.P0) { const bool keep_ = ((selmask >> (kb_ >> 8)) & 1u) != 0u; const float NEG_ = -__builtin_inff(); \
            _Pragma("unroll") for (int r_ = 0; r_ < 16; ++r_) { P0_[r_] = keep_ ? P0_[r_] : NEG_; P1_[r_] = keep_ ? P1_[r_] : NEG_; } } } while (0)
    constexpr int NQL = 8;
#define SEAM_K0() do { VMWN(NQL); SWRITE_HK(0); SBAR(); } while (0)
    f32x16 pA0, pA1, pB0, pB1; float mnA, mnB, alA, alB; bf16x8 pa0, pa1, pa2, pa3;
    SWRITE_HV(0); SBAR();
    if (NT > 1) { SLOAD_H(Kh, Vh, KBASE(1)); }
    SBAR(); qkt<0>(pA0, pA1, K_lds, r32, hi, S.qr);
    MASKT(pA0, pA1, 0); partialSM(pA0, pA1, m_reg, mnA, alA);
    if (NT > 1) { VMW(); SWRITE_H(1); }
    __syncthreads();
#define HALF_STEP(PX0, PX1, mnX, alX, PY0, PY1, alY, t, KB, VB, SB) do {                                                      \
        SBAR(); qkt<KB>(PX0, PX1, K_lds, r32, hi, S.qr);                                             \
        finishSM(PY0, PY1, alY, l_reg, pa0, pa1, pa2, pa3); SBAR();                                                           \
        if ((t) + 1 < NT) { SLOAD_H(Kh, Vh, KBASE((t) + 1)); SBAR(); }                                               \
        pv_tile<VB>(o, vb0, pa0, pa1, pa2, pa3); MASKT(PX0, PX1, (t)); partialSM(PX0, PX1, m_reg, mnX, alX);                                        \
        __syncthreads();                                                                                                      \
        if ((t) + 1 < NT) { VMW(); SWRITE_H(SB); }                                                                          \
        RESC(alX); __syncthreads(); } while (0)
    for (int t = 1; t + 1 < NT; t += 2) {
        HALF_STEP(pB0, pB1, mnB, alB, pA0, pA1, alA, t, 1, 0, 0);
        HALF_STEP(pA0, pA1, mnA, alA, pB0, pB1, alB, t + 1, 0, 1, 1);
    }
    const bool even = (NT & 1) == 0;
    if (even) { SBAR(); qkt<1>(pB0, pB1, K_lds, r32, hi, S.qr); SBAR(); }
    { SLOAD_H(nxt.K, nxt.V, kbn); SBAR();
#pragma unroll
        for (int d0 = 0; d0 < 8; ++d0) S.qr[d0] = load8(nxt.Q + (size_t)(wid * QBLK + r32) * PITCH + d0 * 16 + hi * 8); }
    SBAR();
    finishSM(pA0, pA1, alA, l_reg, pa0, pa1, pa2, pa3); SBAR();
    pv_tile<0>(o, vb0, pa0, pa1, pa2, pa3);
    if (even) { MASKT(pB0, pB1, NT - 1); partialSM(pB0, pB1, m_reg, mnB, alB); __syncthreads(); RESC(alB);
        finishSM(pB0, pB1, alB, l_reg, pa0, pa1, pa2, pa3); SBAR(); pv_tile<1>(o, vb0, pa0, pa1, pa2, pa3); }
    SBAR(); SEAM_K0();
    if (hi == 0) li_l[r32] = l_reg; asm volatile("s_waitcnt lgkmcnt(0)" ::: "memory");
    float rli[16];
#pragma unroll
    for (int r = 0; r < 16; ++r) rli[r] = __builtin_amdgcn_rcpf(li_l[crow(r, hi)]);
    GAS bf16_t* Ow = cur.O + (size_t)(wid * QBLK) * PITCH;
#pragma unroll
    for (int r = 0; r < 16; ++r) { const int orow = crow(r, hi);
#pragma unroll
        for (int d0 = 0; d0 < 4; ++d0) { const float v = o[d0][r] * rli[r];
            const float vn = __shfl_xor(v, 1);
            if ((r32 & 1) == 0) *(GAS unsigned*)(Ow + (size_t)orow * PITCH + d0 * 32 + r32) = cvtpk(v, vn); } }
    __syncthreads();
#undef RESC
#undef KBASE
#undef MASKT
#undef SEAM_K0
#undef HALF_STEP
}

constexpr int A3_V = 0, A3_K = 4 * SHM_V, A3_WS = 4 * SHM_V + 4 * SHM_K + 1024, A3_KMEAN = A3_WS + 2048;
struct Seam3 { bf16x8 qr[8]; bf16x8 v00, v01, v10, v11; };
__device__ __forceinline__ void attn_block3(const GAS bf16_t* Kh, const GAS bf16_t* Vh, GAS bf16_t* Ow, const int P0, const int qlo, const int NS, char* lds, Seam3& S, unsigned selmask, const int tid) {
    const int W = WBIG;
    const int wid = __builtin_amdgcn_readfirstlane(tid >> 6), lane = tid & 63, r32 = lane & 31, hi = lane >> 5, g = wid >> 2;
    const int qm = qlo + r32 - 4 * hi;
    char* V_lds = lds + A3_V + g * SHM_V; char* K_lds = lds + A3_K + g * SHM_K;
    float* ws = (float*)(lds + A3_WS) + wid * 64; float* li_l = ws, * al_l = ws + 32;
    float m_reg = -1e30f, l_reg = 0; f32x16 o[4] = {};
    const int sr = tid >> 4, sc = (tid & 15) * 8, vst0 = v_st(sr, sc), vst1 = v_st(32 + sr, sc);
    const int vb0 = (int)(uintptr_t)V_lds + v_rd_base(lane);
    const unsigned voff = (unsigned)(sr * PITCH + sc) * 2u;
    unsigned koff[2];
#pragma unroll
    for (int i = 0; i < 2; ++i) { const int row = 4 * (2 * wid + i) + (lane >> 4), p = lane & 15; koff[i] = (unsigned)(row * PITCH + ((p ^ (row & 7)) << 3)) * 2u; }
#define KDMA3(step, buf) do { _Pragma("unroll") for (int gq_ = 0; gq_ < 2; ++gq_) { const GAS char* kt_ = (const GAS char*)Kh + (size_t)((2 * (step) + gq_) * KVBLK) * (PITCH * 2); \
        _Pragma("unroll") for (int i_ = 0; i_ < 2; ++i_) __builtin_amdgcn_global_load_lds((const unsigned*)(kt_ + koff[i_]), (LAS unsigned*)((LAS char*)lds + A3_K + ((buf) * 2 + gq_) * SHM_K + (2 * wid + i_) * 1024), 16, 0, 0); } } while (0)
#define VLOAD3(step) do { const GAS char* v0_ = (const GAS char*)Vh + (size_t)((2 * (step)) * KVBLK) * (PITCH * 2); const GAS char* v1_ = v0_ + (size_t)KVBLK * (PITCH * 2); \
        S.v00 = *(const GAS bf16x8*)(v0_ + voff); S.v01 = *(const GAS bf16x8*)(v0_ + voff + 32 * PITCH * 2); S.v10 = *(const GAS bf16x8*)(v1_ + voff); S.v11 = *(const GAS bf16x8*)(v1_ + voff + 32 * PITCH * 2); } while (0)
#define VWRITE3(buf) do { char* vb_ = lds + A3_V + (buf) * 2 * SHM_V; *(bf16x8*)(vb_ + vst0) = S.v00; *(bf16x8*)(vb_ + vst1) = S.v01; *(bf16x8*)(vb_ + SHM_V + vst0) = S.v10; *(bf16x8*)(vb_ + SHM_V + vst1) = S.v11; } while (0)
#define RESC(a) do { if (__any((a) < 1.f)) { if (hi == 0) al_l[r32] = (a); asm volatile("s_waitcnt lgkmcnt(0)" ::: "memory");              \
                     for (int d_ = 0; d_ < 4; ++d_) for (int r = 0; r < 16; ++r) o[d_][r] *= al_l[crow(r, hi)]; } } while (0)
#define KBASE(t) ((2 * (t) + g) * KVBLK)
#define MASKT(P0_, P1_, t) do { const int kb_ = KBASE(t); if (kb_ + KVBLK - 1 > qlo) mask_tile(P0_, P1_, qm - kb_, (unsigned)W); \
        if (kb_ < P0) { const bool keep_ = ((selmask >> (kb_ >> 8)) & 1u) != 0u; const float NEG_ = -__builtin_inff(); \
            _Pragma("unroll") for (int r_ = 0; r_ < 16; ++r_) { P0_[r_] = keep_ ? P0_[r_] : NEG_; P1_[r_] = keep_ ? P1_[r_] : NEG_; } } } while (0)
    f32x16 pA0, pA1, pB0, pB1; float mnA, mnB, alA = 1.f, alB = 1.f; bf16x8 pa0, pa1, pa2, pa3;
    VWRITE3(0); SBAR();
    if (NS > 1) { KDMA3(1, 1); VLOAD3(1); }
    SBAR(); qkt<0>(pA0, pA1, K_lds, r32, hi, S.qr);
    MASKT(pA0, pA1, 0); partialSM(pA0, pA1, m_reg, mnA, alA);
    VMW(); LDS_WAIT(); __syncthreads();
#define HALF_STEP3(PX0, PX1, mnX, alX, PY0, PY1, alY, t, KB, VB, SB) do {                                                     \
        SBAR(); VWRITE3(KB);                                                                                                  \
        if ((t) + 1 < NS) { KDMA3((t) + 1, SB); VLOAD3((t) + 1); } SBAR();             \
        qkt<2 * KB>(PX0, PX1, K_lds, r32, hi, S.qr);                                                                          \
        finishSM(PY0, PY1, alY, l_reg, pa0, pa1, pa2, pa3); SBAR();                                                           \
        pv_tile<2 * VB>(o, vb0, pa0, pa1, pa2, pa3); MASKT(PX0, PX1, (t)); partialSM(PX0, PX1, m_reg, mnX, alX);              \
        RESC(alX);                                                                                                            \
        VMW(); LDS_WAIT(); __syncthreads(); } while (0)
    for (int t = 1; t + 1 < NS; t += 2) {
        HALF_STEP3(pB0, pB1, mnB, alB, pA0, pA1, alA, t, 1, 0, 0);
        HALF_STEP3(pA0, pA1, mnA, alA, pB0, pB1, alB, t + 1, 0, 1, 1);
    }
    const bool even = (NS & 1) == 0;
    if (even) { SBAR(); VWRITE3(1); SBAR(); qkt<2>(pB0, pB1, K_lds, r32, hi, S.qr); SBAR(); }
    finishSM(pA0, pA1, alA, l_reg, pa0, pa1, pa2, pa3); SBAR();
    pv_tile<0>(o, vb0, pa0, pa1, pa2, pa3);
    if (even) { MASKT(pB0, pB1, NS - 1); partialSM(pB0, pB1, m_reg, mnB, alB); RESC(alB);
        LDS_WAIT(); __syncthreads();
        finishSM(pB0, pB1, alB, l_reg, pa0, pa1, pa2, pa3); SBAR(); pv_tile<2>(o, vb0, pa0, pa1, pa2, pa3); }
    __syncthreads();
    constexpr float C2 = 1.4426950408889634f * SCALE;
    float* ob = (float*)(lds + A3_V) + (wid & 3) * 4096;
    if (g == 1) { if (hi == 0) { li_l[r32] = m_reg; al_l[r32] = l_reg; }
#pragma unroll
        for (int d0 = 0; d0 < 4; ++d0)
#pragma unroll
            for (int r = 0; r < 16; ++r) ob[(d0 * 16 + r) * 64 + lane] = o[d0][r]; }
    asm volatile("s_waitcnt lgkmcnt(0)" ::: "memory");
    __syncthreads();
    if (g == 0) { const float* pw = (const float*)(lds + A3_WS) + (wid + 4) * 64;
        const float mB = pw[r32], lB = pw[32 + r32];
        const float m = fmaxf(m_reg, mB), fa = __builtin_amdgcn_exp2f((m_reg - m) * C2), fb = __builtin_amdgcn_exp2f((mB - m) * C2);
        const float inv = __builtin_amdgcn_rcpf(l_reg * fa + lB * fb);
        if (hi == 0) { li_l[r32] = fa * inv; al_l[r32] = fb * inv; }
        asm volatile("s_waitcnt lgkmcnt(0)" ::: "memory");
        LAS unsigned short* tile = (LAS unsigned short*)((LAS char*)lds + A3_K + (wid & 3) * 8704);
#pragma unroll
        for (int r = 0; r < 16; ++r) { const int orow = crow(r, hi); const float wa = li_l[orow], wb = al_l[orow];
#pragma unroll
            for (int d0 = 0; d0 < 4; ++d0) { const float v = o[d0][r] * wa + ob[(d0 * 16 + r) * 64 + lane] * wb;
                tile[orow * 136 + d0 * 32 + r32] = (unsigned short)(cvtpk(v, 0.f) & 0xffffu); } } }
    asm volatile("s_waitcnt lgkmcnt(0)" ::: "memory");
    __syncthreads();
    { const LAS char* tl = (const LAS char*)lds + A3_K + (wid & 3) * 8704;
#pragma unroll
      for (int i = 0; i < 4; ++i) { const int q = lane + 64 * (2 * i + g), row = q >> 4, c16 = q & 15;
          const u32x4 w = *(const LAS u32x4*)(tl + row * 272 + c16 * 16);
          *(GAS u32x4*)(Ow + (size_t)row * PITCH + c16 * 8) = w; } }
    __syncthreads();
#undef RESC
#undef KBASE
#undef MASKT
#undef HALF_STEP3
#undef KDMA3
#undef VLOAD3
#undef VWRITE3
}
#undef ROW
#undef VMWN
#undef SLOAD_H
#undef SWRITE_HK
#undef SWRITE_HV
#undef SWRITE_H

__device__ __forceinline__ void attn_unit(int b, int h, int qb, const GAS bf16_t* Q, const GAS bf16_t* K, const GAS bf16_t* V, GAS bf16_t* O, const GAS float* ksum, char* lds, const int tid) {
    const int lane = tid & 63, hi = lane >> 5;
    const size_t hb = (size_t)b * SEQ * PITCH + (size_t)h * D;
    BlockRef cur; cur.Q = Q + hb + (size_t)qb * QB * PITCH; cur.K = K + hb; cur.V = V + hb; cur.O = O + hb + (size_t)qb * QB * PITCH; cur.P0 = qb * QB;
    Seam S;
    attn_prime(cur, lds, S, tid);
    float* kmean = (float*)(lds + KMEAN_OFF);
    { for (int i = tid; i < qb * 128; i += 512) { const int j = i >> 7, d = i & 127; const GAS float* kp = ksum + ((size_t)(b * 8 + j) * 2) * 1024 + h * D + d;
          kmean[i] = (kp[0] + kp[1024]) * (1.0f / 256.0f); }
      __syncthreads(); }
    unsigned selmask = 0u;
    { float gate[7];
#pragma unroll
      for (int j = 0; j < 7; ++j) {
          if (j < qb) { float s = 0.f;
#pragma unroll
              for (int d0 = 0; d0 < 8; ++d0) { const float* km = kmean + j * 128 + d0 * 16 + hi * 8;
#pragma unroll
                  for (int i = 0; i < 8; ++i) s += bf2f((unsigned short)S.qr[d0][i]) * km[i]; }
              s += __shfl_xor(s, 32); gate[j] = s; }
          else gate[j] = -__builtin_inff(); }
#pragma unroll
      for (int k = 0; k < 3; ++k) { float best = -__builtin_inff(); int bi = -1;
#pragma unroll
          for (int j = 0; j < 7; ++j) { const bool cand = ((selmask >> j) & 1u) == 0u && gate[j] > best; if (cand) { best = gate[j]; bi = j; } }
          if (bi >= 0) selmask |= 1u << bi; } }
    attn_block(cur, cur, lds, S, selmask, tid);
}
__device__ __forceinline__ void attn_unit3(int b, int h, int qb, int half, const GAS bf16_t* Q, const GAS bf16_t* K, const GAS bf16_t* V, GAS bf16_t* O, const GAS float* ksum, char* lds, const int tid) {
    const int lane = tid & 63, r32 = lane & 31, hi = lane >> 5, wid = __builtin_amdgcn_readfirstlane(tid >> 6);
    const size_t hb = (size_t)b * SEQ * PITCH + (size_t)h * D;
    const int qrow = qb * QB + half * 128 + (wid & 3) * QBLK, NS = 2 * qb + half + 1;
    Seam3 S;
    { const GAS bf16_t* Qw = Q + hb + (size_t)qrow * PITCH;
      for (int d0 = 0; d0 < 8; ++d0) S.qr[d0] = load8(Qw + (size_t)r32 * PITCH + d0 * 16 + hi * 8);
      const int sr = tid >> 4, sc = (tid & 15) * 8; const unsigned voff = (unsigned)(sr * PITCH + sc) * 2u;
#pragma unroll
      for (int gq = 0; gq < 2; ++gq)
#pragma unroll
          for (int i = 0; i < 2; ++i) { const int row = 4 * (2 * wid + i) + (lane >> 4), p = lane & 15;
              __builtin_amdgcn_global_load_lds((const unsigned*)((const GAS char*)(K + hb) + (size_t)(gq * KVBLK) * (PITCH * 2) + (unsigned)(row * PITCH + ((p ^ (row & 7)) << 3)) * 2u),
                                               (LAS unsigned*)((LAS char*)lds + A3_K + gq * SHM_K + (2 * wid + i) * 1024), 16, 0, 0); }
      const GAS char* v0 = (const GAS char*)(V + hb); const GAS char* v1 = v0 + (size_t)KVBLK * (PITCH * 2);
      S.v00 = *(const GAS bf16x8*)(v0 + voff); S.v01 = *(const GAS bf16x8*)(v0 + voff + 32 * PITCH * 2); S.v10 = *(const GAS bf16x8*)(v1 + voff); S.v11 = *(const GAS bf16x8*)(v1 + voff + 32 * PITCH * 2); }
    float* kmean = (float*)(lds + A3_KMEAN);
    { for (int i = tid; i < qb * 128; i += 512) { const int j = i >> 7, d = i & 127; const GAS float* kp = ksum + ((size_t)(b * 8 + j) * 2) * 1024 + h * D + d;
          kmean[i] = (kp[0] + kp[1024]) * (1.0f / 256.0f); }
      VMW(); __syncthreads(); }
    unsigned selmask = 0u;
    { float gate[7];
#pragma unroll
      for (int j = 0; j < 7; ++j) {
          if (j < qb) { float s = 0.f;
#pragma unroll
              for (int d0 = 0; d0 < 8; ++d0) { const float* km = kmean + j * 128 + d0 * 16 + hi * 8;
#pragma unroll
                  for (int i = 0; i < 8; ++i) s += bf2f((unsigned short)S.qr[d0][i]) * km[i]; }
              s += __shfl_xor(s, 32); gate[j] = s; }
          else gate[j] = -__builtin_inff(); }
#pragma unroll
      for (int k = 0; k < 3; ++k) { float best = -__builtin_inff(); int bi = -1;
#pragma unroll
          for (int j = 0; j < 7; ++j) { const bool cand = ((selmask >> j) & 1u) == 0u && gate[j] > best; if (cand) { best = gate[j]; bi = j; } }
          if (bi >= 0) selmask |= 1u << bi; } }
    int tb = tid; asm volatile("" : "+v"(tb));
    attn_block3(K + hb, V + hb, O + hb + (size_t)qrow * PITCH, qb * QB, qrow, NS, lds, S, selmask, tb);
}
#undef VMW
}

#define XB_TMO      128
#define XB_XCNT(j)  (256  + 64 * (j))
#define XB_XSUB(j)  (1280 + 64 * (j))
#define XB_XGEN(j)  (2304 + 64 * (j))
#define XB_TOP      3328
#define XB_TOPGEN   3392
#define XCD_BAR_WORDS 3456
#define XB_SPIN_CAP (1u << 18)
__device__ __forceinline__ unsigned xb_ld(unsigned* p)              { return __hip_atomic_load(p, __ATOMIC_RELAXED, __HIP_MEMORY_SCOPE_AGENT); }
__device__ __forceinline__ unsigned xb_add(unsigned* p, unsigned v) { return __hip_atomic_fetch_add(p, v, __ATOMIC_RELAXED, __HIP_MEMORY_SCOPE_AGENT); }
__device__ __forceinline__ unsigned xb_xcc_id() { return (unsigned)__builtin_amdgcn_s_getreg((3 << 11) | 20) & 0xFu; }
#define XB_SPIN(cond, bar) do { unsigned _sp = 0; while (cond) { __builtin_amdgcn_s_sleep(1); \
    if ((++_sp & 255u) == 0u) { if (xb_ld(&(bar)[XB_TMO])) break; if (_sp > XB_SPIN_CAP) { atomicAdd(&(bar)[XB_TMO], 1u); break; } } } } while (0)
struct XcdBarrier { unsigned* bar; unsigned x; volatile LAS unsigned* st; };
__device__ __forceinline__ XcdBarrier xcd_barrier_post(unsigned* bar, volatile LAS unsigned* st) {
    XcdBarrier b; b.bar = bar; b.x = xb_xcc_id(); b.st = st;
    if (threadIdx.x == 0) (void)xb_add(&bar[XB_XCNT(b.x)], 1u);
    return b;
}
__device__ __forceinline__ void xcd_barrier_complete(unsigned* bar, unsigned x, unsigned& nloc, unsigned& nx) {
    const unsigned G = gridDim.x * gridDim.y * gridDim.z;
    unsigned sum, cnt, mine, sp = 0u;
    for (;;) {
        sum = 0u; cnt = 0u; mine = 0u;
#pragma unroll
        for (unsigned j = 0; j < 16; ++j) { const unsigned c = xb_ld(&bar[XB_XCNT(j)]); sum += c; cnt += (c > 0u) ? 1u : 0u; mine = (j == x) ? c : mine; }
        if (sum == G) break;
        __builtin_amdgcn_s_sleep(1);
        if ((++sp & 255u) == 0u) { if (xb_ld(&bar[XB_TMO])) break; if (sp > XB_SPIN_CAP) { atomicAdd(&bar[XB_TMO], 1u); break; } }
    }
    nloc = mine > 0u ? mine : 1u; nx = cnt > 0u ? cnt : 1u;
}
__device__ __forceinline__ void xcd_barrier(const XcdBarrier& b, const bool first_thread) {
    asm volatile("s_waitcnt vmcnt(0)" ::: "memory");
    __syncthreads();
    if (first_thread) {
        unsigned* bar = b.bar;
        __builtin_amdgcn_s_waitcnt(0);
        unsigned nloc = b.st[0], nx = b.st[1];
        if (nloc == 0u) { xcd_barrier_complete(bar, b.x, nloc, nx); b.st[0] = nloc; b.st[1] = nx; }
        const unsigned old = xb_add(&bar[XB_XSUB(b.x)], 1u);
        const unsigned gen = old / nloc;
        if (old + 1u == (gen + 1u) * nloc) {
            __builtin_amdgcn_fence(__ATOMIC_RELEASE, "agent");
            asm volatile("s_waitcnt vmcnt(0)" ::: "memory");
            const unsigned og = xb_add(&bar[XB_TOP], 1u);
            const unsigned tg = og / nx;
            if (og + 1u == (tg + 1u) * nx) xb_add(&bar[XB_TOPGEN], 1u);
            else XB_SPIN(xb_ld(&bar[XB_TOPGEN]) == tg, bar);
            __builtin_amdgcn_fence(__ATOMIC_ACQUIRE, "agent");
            xb_add(&bar[XB_XGEN(b.x)], 1u);
            asm volatile("s_waitcnt vmcnt(0)" ::: "memory");
        } else {
            XB_SPIN(xb_ld(&bar[XB_XGEN(b.x)]) == gen, bar);
            __builtin_amdgcn_fence(__ATOMIC_ACQUIRE, "agent");
            asm volatile("s_waitcnt vmcnt(0)" ::: "memory");
        }
    }
    __syncthreads();
}

#ifndef BAR2
#define BAR2 1
#endif
__device__ __forceinline__ void xcd_barrier2(unsigned* bar, const unsigned x, volatile LAS unsigned* st, const int tid) {
    asm volatile("s_waitcnt vmcnt(0)" ::: "memory");
    __syncthreads();
    if (tid < 64) {
        unsigned k = 0u;
        if (tid == 0) {
            __builtin_amdgcn_s_waitcnt(0);
            unsigned nloc = st[0], nx = st[1];
            if (nloc == 0u) { xcd_barrier_complete(bar, x, nloc, nx); st[0] = nloc; st[1] = nx; unsigned mask = 0u;
#pragma unroll
                for (unsigned j = 0; j < 16; ++j) mask |= (xb_ld(&bar[XB_XCNT(j)]) > 0u ? 1u : 0u) << j;
                st[2] = mask; }
            const unsigned old = xb_add(&bar[XB_XSUB(x)], 1u);
            k = old / nloc + 1u;
            if (old + 1u == k * nloc) { __builtin_amdgcn_fence(__ATOMIC_RELEASE, "agent"); asm volatile("s_waitcnt vmcnt(0)" ::: "memory");
                (void)__hip_atomic_fetch_add(&bar[XB_XGEN(x)], 1u, __ATOMIC_RELAXED, __HIP_MEMORY_SCOPE_AGENT); }
        }
        k = (unsigned)__builtin_amdgcn_readfirstlane((int)k);
        asm volatile("s_waitcnt lgkmcnt(0)" ::: "memory");
        const unsigned mask = st[2]; const bool part = ((mask >> (tid & 15)) & 1u) != 0u;
        unsigned* p = &bar[XB_XGEN(tid & 15)];
        for (unsigned sp = 0; sp < XB_SPIN_CAP; ++sp) { unsigned v = k; if (tid < 16 && part) v = xb_ld(p);
            if (__all(v >= k)) break; __builtin_amdgcn_s_sleep(1); }
        __builtin_amdgcn_fence(__ATOMIC_ACQUIRE, "agent");
        asm volatile("s_waitcnt vmcnt(0) lgkmcnt(0)" ::: "memory");
    }
    __syncthreads();
}

struct CvItem { const GAS float* W; GAS bf16_t* WT; const GAS float* gain; int K, N, k0, n0, drow0; };
constexpr int CV_P = 16 * 32, CV_O = 32 * 32, CV_F = 2816, CV_MIX = 2 * CV_P + CV_O;
constexpr int CV_END_MIX0 = CV_MIX, CV_END_DDOWN = CV_MIX + 0 * CV_F, CV_END_MIX1 = CV_END_DDOWN + CV_MIX, CV_TOTAL = CV_END_MIX1;
constexpr int CV_END_WIN0 = 0, CV_END_WPB0 = 0, CV_END_WO0 = 0, CV_END_DUP = 0, CV_END_WIN1 = 0, CV_END_WPB1 = 0, CV_END_WO1 = 0, CV_END_EGU = 0;
__device__ __forceinline__ void cv_set(CvItem& d, const GAS float* W, int K, int N, GAS bf16_t* WT, const GAS float* gain, int mode, int r) {
    const int nblk = N / 64, kb = r / nblk, nb = r - kb * nblk; d.W = W; d.WT = WT; d.gain = gain; d.K = K; d.N = N; d.k0 = 64 * kb; d.n0 = 64 * nb;
    const int n0 = d.n0; d.drow0 = mode == 0 ? n0 : (256 * (n0 >> 7) + (n0 & 127) + (mode == 2 ? 128 : 0));
}
__device__ __forceinline__ void cv_mixer(CvItem& d, const float* const* in, GAS unsigned char* ws, int l, int r) {
    if (r < CV_P) { cv_set(d, (const GAS float*)in[6] + (size_t)l * AW * DM, AW, DM, (GAS bf16_t*)(ws + WS_WPA) + (size_t)l * 2 * DM * AW, nullptr, 0, r); return; } r -= CV_P;
    if (r < CV_P) { cv_set(d, (const GAS float*)in[7] + (size_t)l * SW * DM, SW, DM, (GAS bf16_t*)(ws + WS_WPA) + (size_t)l * 2 * DM * AW + (size_t)DM * AW, nullptr, 0, r); return; } r -= CV_P;
    cv_set(d, (const GAS float*)in[8] + (size_t)l * DM * DM, DM, DM, (GAS bf16_t*)(ws + WS_WO) + (size_t)l * DM * DM, nullptr, 0, r);
}
__device__ __forceinline__ void cv_decode(CvItem& d, const float* const* in, GAS unsigned char* ws, int g) {
    if (g < CV_END_MIX0) { cv_mixer(d, in, ws, 0, g); return; }
    if (g < CV_END_DDOWN) { cv_set(d, (const GAS float*)in[12], FF, DM, (GAS bf16_t*)(ws + WS_WD), nullptr, 0, g - CV_END_MIX0); return; }
    cv_mixer(d, in, ws, 1, g - CV_END_DDOWN);
}
__device__ __forceinline__ void cv_load(const CvItem& d, int lane, f32x4 (&v)[16], float (&gv)[16]) {
    const int r = lane >> 4, c4 = lane & 15;
#pragma unroll
    for (int i = 0; i < 8; ++i)
#pragma unroll
        for (int p = 0; p < 2; ++p) { const int k = d.k0 + 8 * i + 2 * r + p; v[2 * i + p] = __builtin_nontemporal_load((const GAS f32x4*)(d.W + (size_t)k * d.N + d.n0 + 4 * c4)); gv[2 * i + p] = d.gain ? d.gain[k] : 1.0f; }
}
__device__ __forceinline__ void cv_finish(const CvItem& d, int lane, const f32x4 (&v)[16], const float (&gv)[16], LAS unsigned* scr) {
    const int r = lane >> 4, c4 = lane & 15;
#pragma unroll
    for (int i = 0; i < 8; ++i) { const f32x4 a = v[2 * i] * gv[2 * i], b = v[2 * i + 1] * gv[2 * i + 1];
#pragma unroll
        for (int j = 0; j < 4; ++j) scr[(4 * c4 + j) * 36 + 4 * i + r] = cvt_pk_bf16(a[j], b[j]); }
    LDS_WAIT(); asm volatile("" ::: "memory");
    const int rn = lane >> 3, c = lane & 7;
#pragma unroll
    for (int m = 0; m < 8; ++m) { const int n = rn + 8 * m; const u32x4 o = *(const LAS u32x4*)(scr + n * 36 + 4 * c);
        __builtin_nontemporal_store(o, (GAS u32x4*)(d.WT + (size_t)(d.drow0 + n) * d.K + d.k0 + 8 * c)); }
    LDS_WAIT(); asm volatile("" ::: "memory");
}
template <bool LOOK> __device__ __forceinline__ void bg_convert(const float* const* in, GAS unsigned char* ws, unsigned* ctl, LAS unsigned char* lds, volatile LAS unsigned* flagw, int lane, int wave, int bx, int G, int must, int phase, int nlook) {
    const int q = bx & 7; unsigned* head = ctl + CW_QH + 64 * q; unsigned* done = ctl + CW_DONE + 64 * phase;
    LAS unsigned* scr = (LAS unsigned*)(lds + wave * 16384);
    const bool look = LOOK && wave != 0 && wave <= nlook;
    const unsigned fl = (unsigned)phase + 1u;
    bool skip = false;
    { const int g0 = (int)__builtin_amdgcn_readfirstlane(__hip_atomic_load(head, __ATOMIC_RELAXED, __HIP_MEMORY_SCOPE_AGENT)) * 8 + q;
      if (g0 >= CV_TOTAL) skip = true;
      else if (g0 >= must) { if (!LOOK) skip = true; else if ((int)__builtin_amdgcn_readfirstlane(__hip_atomic_load(done, __ATOMIC_RELAXED, __HIP_MEMORY_SCOPE_AGENT)) >= G) skip = true; else skip = !look; } }
    if (!skip) {
#define CV_PULL(dst, lastg) do { bool more_ = (lastg) + 8 < must; if (look && !more_) more_ = flagw[0] != fl; \
        dst = 0x0fffffffu; if (more_ && lane == 0) dst = __hip_atomic_fetch_add(head, 1u, __ATOMIC_RELAXED, __HIP_MEMORY_SCOPE_AGENT); } while (0)
        unsigned pulled = 0u; if (lane == 0) pulled = __hip_atomic_fetch_add(head, 1u, __ATOMIC_RELAXED, __HIP_MEMORY_SCOPE_AGENT);
        int gA = (int)__builtin_amdgcn_readfirstlane(pulled) * 8 + q;
        if (gA < CV_TOTAL) {
            CvItem dA, dB; f32x4 vA[16], vB[16]; float gvA[16], gvB[16];
            cv_decode(dA, in, ws, gA); cv_load(dA, lane, vA, gvA);
            unsigned pb_; CV_PULL(pb_, gA);
            int gB = (int)__builtin_amdgcn_readfirstlane(pb_) * 8 + q;
            for (;;) {
                unsigned pc_ = 0x0fffffffu;
                if (gB < CV_TOTAL) { CV_PULL(pc_, gB); cv_decode(dB, in, ws, gB); cv_load(dB, lane, vB, gvB); }
                cv_finish(dA, lane, vA, gvA, scr);
                if (gB >= CV_TOTAL) break;
                dA = dB; gA = gB;
#pragma unroll
                for (int i = 0; i < 16; ++i) { vA[i] = vB[i]; gvA[i] = gvB[i]; }
                gB = (int)__builtin_amdgcn_readfirstlane(pc_) * 8 + q;
            }
        }
#undef CV_PULL
    }
    if (LOOK && wave == 0) {
        for (unsigned sp = 0; sp < (1u << 22); ++sp) {
            if ((int)__builtin_amdgcn_readfirstlane(__hip_atomic_load(done, __ATOMIC_RELAXED, __HIP_MEMORY_SCOPE_AGENT)) >= G) break;
            if ((int)__builtin_amdgcn_readfirstlane(__hip_atomic_load(head, __ATOMIC_RELAXED, __HIP_MEMORY_SCOPE_AGENT)) * 8 + q >= CV_TOTAL) break;
            __builtin_amdgcn_s_sleep(8); }
        if (lane == 0) flagw[0] = fl;
    }
}
__device__ __forceinline__ void rms_row(const GAS float* xrow, int lane, f32x4 (&v)[8]) {
    const GAS f32x4* xr = (const GAS f32x4*)xrow + lane; float s = 0.f;
#pragma unroll
    for (int j = 0; j < 8; ++j) { v[j] = xr[64 * j]; s += (v[j].x * v[j].x + v[j].y * v[j].y) + (v[j].z * v[j].z + v[j].w * v[j].w); }
    const float rstd = 1.0f / sqrtf(wave_sum(s) * (1.0f / DM) + EPS);
#pragma unroll
    for (int j = 0; j < 8; ++j) v[j] = v[j] * rstd;
}
__device__ __forceinline__ void rms_row_bf(const GAS bf16_t* xrow, int lane, f32x4 (&v)[8]) {
    const GAS u32x2* xr = (const GAS u32x2*)xrow + lane; float s = 0.f;
#pragma unroll
    for (int j = 0; j < 8; ++j) { const u32x2 w = xr[64 * j]; v[j] = (f32x4){bflo(w.x), bfhi(w.x), bflo(w.y), bfhi(w.y)}; s += (v[j].x * v[j].x + v[j].y * v[j].y) + (v[j].z * v[j].z + v[j].w * v[j].w); }
    const float rstd = 1.0f / sqrtf(wave_sum(s) * (1.0f / DM) + EPS);
#pragma unroll
    for (int j = 0; j < 8; ++j) v[j] = v[j] * rstd;
}
__device__ __forceinline__ void store_row_bf16(GAS bf16_t* orow, int lane, const f32x4 (&v)[8]) {
    GAS u32x2* o8 = (GAS u32x2*)orow + lane;
#pragma unroll
    for (int j = 0; j < 8; ++j) { u32x2 w; w.x = cvt_pk_bf16(v[j].x, v[j].y); w.y = cvt_pk_bf16(v[j].z, v[j].w); o8[64 * j] = w; }
}

__device__ __forceinline__ void store_row_i8(GAS unsigned* row8, GAS float* sc, int lane, const f32x4 (&v)[8]) {
    float am = 0.f;
#pragma unroll
    for (int j = 0; j < 8; ++j) am = fmaxf(am, fmaxf(fmaxf(fabsf(v[j].x), fabsf(v[j].y)), fmaxf(fabsf(v[j].z), fabsf(v[j].w))));
    am = wave_max(am); const float inv = am > 0.f ? 127.0f / am : 0.f;
#pragma unroll
    for (int j = 0; j < 8; ++j) row8[64 * j + lane] = pack_i8x4(v[j], inv);
    if (lane == 0) *sc = am > 0.f ? am * (1.0f / 127.0f) : 1.0f;
}
constexpr int Q8_FF_STRIPS = FF / 32, Q8_IN_STRIPS = INW / 32, Q8_STRIPS = 18 * Q8_FF_STRIPS + 2 * Q8_IN_STRIPS;
constexpr int Q8_CMAX_OFF = RING_BYTES + 8192;
__device__ __forceinline__ void q8_strip(const float* const* in, GAS unsigned char* ws, LAS unsigned char* lds, int s, int tid) {
    const int lane = tid & 63, wid = __builtin_amdgcn_readfirstlane(tid >> 6);
    const GAS float* W; const GAS float* gain; GAS unsigned char* dst; GAS float* sb = (GAS float*)(ws + WS_SB); int N, n0, drow0;
    if (s < 18 * Q8_FF_STRIPS) { const int mtx = s / Q8_FF_STRIPS, t = s - mtx * Q8_FF_STRIPS; N = FF; n0 = 32 * t;
        const int up = mtx & 1, e = (mtx >> 1) - 1; drow0 = 256 * (n0 >> 7) + (n0 & 127) + (up ? 128 : 0);
        if (mtx < 2) { W = (const GAS float*)in[up ? 11 : 10]; gain = (const GAS float*)in[9]; dst = ws + WS_WGU; }
        else { W = (const GAS float*)in[up ? 16 : 15] + (size_t)e * DM * FF; gain = (const GAS float*)in[9] + DM; dst = ws + WS_WEGU + (size_t)e * (2 * FF) * P8B; sb += 11264 * (1 + e); } }
    else { const int r = s - 18 * Q8_FF_STRIPS, l = r / Q8_IN_STRIPS, t = r - l * Q8_IN_STRIPS; N = INW; n0 = 32 * t; drow0 = n0;
        W = (const GAS float*)in[2] + (size_t)l * DM * INW; gain = (const GAS float*)in[1] + l * DM; dst = ws + WS_WIN + (size_t)l * INW * P8B; sb += SB_WIN + l * INW; }
    LAS unsigned* img = (LAS unsigned*)lds;
    LAS unsigned* cmax = (LAS unsigned*)(lds + Q8_CMAX_OFF);
    if (tid < 32) cmax[tid] = 0u;
    __syncthreads();
    { const int r = lane >> 3, c4 = lane & 7; float mx[4] = {0.f, 0.f, 0.f, 0.f};
#pragma unroll 1
      for (int b = 0; b < 4; ++b) { const int kb = wid * 256 + b * 64; f32x4 v[8]; float gv[8];
#pragma unroll
          for (int i = 0; i < 4; ++i)
#pragma unroll
              for (int p = 0; p < 2; ++p) { const int k = kb + 16 * i + 2 * r + p; v[2 * i + p] = __builtin_nontemporal_load((const GAS f32x4*)(W + (size_t)k * N + n0 + 4 * c4)); gv[2 * i + p] = gain[k]; }
#pragma unroll
          for (int i = 0; i < 4; ++i) { const f32x4 a = v[2 * i] * gv[2 * i], bq = v[2 * i + 1] * gv[2 * i + 1]; const int kd = (kb + 16 * i + 2 * r) >> 1;
#pragma unroll
              for (int j = 0; j < 4; ++j) { const unsigned w = cvt_pk_bf16(a[j], bq[j]); mx[j] = fmaxf(mx[j], fmaxf(fabsf(bflo(w)), fabsf(bfhi(w)))); img[(4 * c4 + j) * 1024 + (kd ^ (c4 << 3))] = w; } } }
#pragma unroll
      for (int j = 0; j < 4; ++j) { float m = mx[j]; m = fmaxf(m, __shfl_xor(m, 8)); m = fmaxf(m, __shfl_xor(m, 16)); m = fmaxf(m, __shfl_xor(m, 32));
          if (r == 0) atomicMax((unsigned*)(cmax + 4 * c4 + j), __float_as_uint(m)); } }
    LDS_WAIT(); __syncthreads();
#pragma unroll
    for (int q = 0; q < 4; ++q) { const int n = wid * 4 + q; const float am = __uint_as_float(cmax[n]); const float inv = am > 0.f ? 127.0f / am : 0.f; const int sw = (n >> 2) << 3;
        GAS unsigned char* rp = dst + (size_t)(drow0 + n) * P8B;
#pragma unroll
        for (int j = 0; j < 4; ++j) { const int d = 4 * (lane + 64 * j); const u32x4 c = *(const LAS u32x4*)(img + n * 1024 + (d ^ sw));
            u32x2 o; o.x = pack_i8x4((f32x4){bflo(c.x), bfhi(c.x), bflo(c.y), bfhi(c.y)}, inv); o.y = pack_i8x4((f32x4){bflo(c.z), bfhi(c.z), bflo(c.w), bfhi(c.w)}, inv);
            __builtin_nontemporal_store(o, (GAS u32x2*)(rp + 8 * (lane + 64 * j))); }
        if (lane == 0) sb[drow0 + n] = am > 0.f ? am * (1.0f / 127.0f) : 1.0f; }
    __syncthreads();
}
#ifndef Q8D_REG
#define Q8D_REG 1
#endif
constexpr int Q8D_STRIPS = Q8D_REG ? 9 * (DM / 16) : 8 * (DM / 32);
__device__ __forceinline__ void q8_strip_down_reg(const float* const* in, GAS unsigned char* ws, LAS unsigned char* lds, int s, int tid) {
    const int e = s >> 7, n0 = 16 * (s & 127), c4 = tid & 3, g = tid >> 2;
    const GAS float* src = (e < 8 ? (const GAS float*)in[17] + (size_t)e * FF * DM : (const GAS float*)in[12]) + (size_t)(44 * g) * DM + n0 + 4 * c4;
    GAS unsigned char* dst = (e < 8 ? ws + WS_WED + (size_t)(e * DM) * (FF * 2) : ws + WS_WD) + (size_t)n0 * (FF * 2); GAS float* sb = (GAS float*)(ws + WS_SB) + (e < 8 ? SB_WED + e * DM : SB_WD) + n0;
    LAS unsigned* cmax = (LAS unsigned*)(lds + Q8_CMAX_OFF); LAS unsigned* img = (LAS unsigned*)lds;
    if (tid < 16) cmax[tid] = 0u;
    unsigned pk[22][4]; float mx[4] = {0.f, 0.f, 0.f, 0.f};
#pragma unroll
    for (int b = 0; b < 11; ++b) { f32x4 v[4];
#pragma unroll
        for (int p = 0; p < 4; ++p) v[p] = __builtin_nontemporal_load((const GAS f32x4*)(src + (size_t)(4 * b + p) * DM));
#pragma unroll
        for (int j = 0; j < 4; ++j) { mx[j] = fmaxf(mx[j], fmaxf(fmaxf(fabsf(v[0][j]), fabsf(v[1][j])), fmaxf(fabsf(v[2][j]), fabsf(v[3][j]))));
            pk[2 * b][j] = cvt_pk_bf16(v[0][j], v[1][j]); pk[2 * b + 1][j] = cvt_pk_bf16(v[2][j], v[3][j]); }
        if (b & 1) asm volatile("" ::: "memory"); }
    __syncthreads();
#pragma unroll
    for (int j = 0; j < 4; ++j) { float m = mx[j]; m = fmaxf(m, __shfl_xor(m, 4)); m = fmaxf(m, __shfl_xor(m, 8)); m = fmaxf(m, __shfl_xor(m, 16)); m = fmaxf(m, __shfl_xor(m, 32));
        if ((tid & 60) == 0) atomicMax((unsigned*)(cmax + 4 * c4 + j), __float_as_uint(m)); }
    LDS_WAIT(); __syncthreads();
    float inv[4];
#pragma unroll
    for (int j = 0; j < 4; ++j) { const float am = bflo(cvt_pk_bf16(__uint_as_float(cmax[4 * c4 + j]), 0.f)); inv[j] = am > 0.f ? 127.0f / am : 0.f; }
#pragma unroll
    for (int d = 0; d < 11; ++d)
#pragma unroll
        for (int j = 0; j < 4; ++j) { const unsigned lo = pk[2 * d][j], hi = pk[2 * d + 1][j];
            img[(4 * c4 + j) * 1412 + 11 * g + d] = pack_i8x4((f32x4){bflo(lo), bfhi(lo), bflo(hi), bfhi(hi)}, inv[j]); }
    LDS_WAIT(); __syncthreads();
#pragma unroll 1
    for (int i = tid; i < 16 * 352; i += 512) { const int n = i / 352, c = i - n * 352; const LAS unsigned* tp = img + n * 1412 + 4 * c;
        u32x4 o; o.x = tp[0]; o.y = tp[1]; o.z = tp[2]; o.w = tp[3];
        *(GAS u32x4*)(dst + (size_t)n * (FF * 2) + 16 * c) = o; }
    if (tid < 16) { const float am = bflo(cvt_pk_bf16(__uint_as_float(cmax[tid]), 0.f)); sb[tid] = am > 0.f ? am * (1.0f / 127.0f) : 1.0f; }
    __syncthreads();
}
__device__ __forceinline__ void q8_strip_down(const float* const* in, GAS unsigned char* ws, LAS unsigned char* lds, int s, int tid) {
    const int lane = tid & 63, wid = __builtin_amdgcn_readfirstlane(tid >> 6);
    const int e = s / (DM / 32), t = s - e * (DM / 32), n0 = 32 * t;
    const GAS float* W = (const GAS float*)in[17] + (size_t)e * FF * DM; GAS unsigned char* dst = ws + WS_WED + (size_t)(e * DM + n0) * (FF * 2); GAS float* sb = (GAS float*)(ws + WS_SB) + SB_WED + e * DM + n0;
    LAS unsigned* cmax = (LAS unsigned*)(lds + Q8_CMAX_OFF); LAS unsigned* tile = (LAS unsigned*)(lds + wid * 4096);
    if (tid < 32) cmax[tid] = 0u;
    __syncthreads();
    const int r = lane >> 3, c4 = lane & 7;
    { float mx[4] = {0.f, 0.f, 0.f, 0.f};
#pragma unroll 1
      for (int b = 0; b < 11; ++b) { const int kb = wid * 704 + b * 64; f32x4 v[8];
#pragma unroll
          for (int i = 0; i < 2; ++i)
#pragma unroll
              for (int p = 0; p < 4; ++p) v[4 * i + p] = *(const GAS f32x4*)(W + (size_t)(kb + 32 * i + 4 * r + p) * DM + n0 + 4 * c4);
#pragma unroll
          for (int q = 0; q < 8; ++q)
#pragma unroll
              for (int j = 0; j < 4; ++j) mx[j] = fmaxf(mx[j], fabsf(v[q][j])); }
#pragma unroll
      for (int j = 0; j < 4; ++j) { float m = mx[j]; m = fmaxf(m, __shfl_xor(m, 8)); m = fmaxf(m, __shfl_xor(m, 16)); m = fmaxf(m, __shfl_xor(m, 32));
          if (r == 0) atomicMax((unsigned*)(cmax + 4 * c4 + j), __float_as_uint(m)); } }
    LDS_WAIT(); __syncthreads();
    { float inv[4];
#pragma unroll
      for (int j = 0; j < 4; ++j) { const float am = __uint_as_float(cmax[4 * c4 + j]); inv[j] = am > 0.f ? 127.0f / am : 0.f; }
#pragma unroll 1
      for (int b = 0; b < 11; ++b) { const int kb = wid * 704 + b * 64; f32x4 v[8];
#pragma unroll
          for (int i = 0; i < 2; ++i)
#pragma unroll
              for (int p = 0; p < 4; ++p) v[4 * i + p] = *(const GAS f32x4*)(W + (size_t)(kb + 32 * i + 4 * r + p) * DM + n0 + 4 * c4);
#pragma unroll
          for (int i = 0; i < 2; ++i)
#pragma unroll
              for (int j = 0; j < 4; ++j) tile[(4 * c4 + j) * 17 + 8 * i + r] = pack_i8x4((f32x4){v[4 * i][j], v[4 * i + 1][j], v[4 * i + 2][j], v[4 * i + 3][j]}, inv[j]);
          LDS_WAIT(); asm volatile("" ::: "memory");
#pragma unroll
          for (int m = 0; m < 2; ++m) { const int n = (lane >> 2) + 16 * m, c = lane & 3; const LAS unsigned* tp = tile + n * 17 + 4 * c;
              u32x4 o; o.x = tp[0]; o.y = tp[1]; o.z = tp[2]; o.w = tp[3];
              *(GAS u32x4*)(dst + (size_t)n * (FF * 2) + kb + 16 * c) = o; }
          LDS_WAIT(); asm volatile("" ::: "memory"); } }
    if (tid < 32) { const float am = __uint_as_float(cmax[tid]); sb[tid] = am > 0.f ? am * (1.0f / 127.0f) : 1.0f; }
    __syncthreads();
}
constexpr int SGU_LDV = 136;
constexpr int SGU_STATS_OFF = 2 * 128 * SGU_LDV * 2;
__device__ __forceinline__ void sgu_unit(int b, int chunk, int gp, const GAS bf16_t* U, const GAS bf16_t* VG, GAS bf16_t* OUT, const GAS float* gsgu, const GAS bf16_t* wst  , const GAS float* bs  , const GAS f32x2* vgst, LAS unsigned char* lds, const int tid) {
    const int lane = tid & 63, wid = __builtin_amdgcn_readfirstlane(tid >> 6);
    const int tok0 = b * SEQ + chunk * 128;
    LAS float* stats = (LAS float*)(lds + SGU_STATS_OFF);
    LAS bf16_t* vnT = (LAS bf16_t*)lds;
    if (tid < 128) { const GAS f32x4* p = (const GAS f32x4*)(vgst + (size_t)(tok0 + tid) * 16); float sm = 0.f, sq = 0.f;
#pragma unroll
        for (int i = 0; i < 8; ++i) { const f32x4 v = p[i]; sm += v.x + v.z; sq += v.y + v.w; }
        const float mean = sm * (1.0f / SW); const float var = fmaxf(sq * (1.0f / SW) - mean * mean, 0.f);
        stats[2 * tid] = mean; stats[2 * tid + 1] = 1.0f / sqrtf(var + EPS); }
    LDS_WAIT(); __syncthreads();
    { const int s = tid & 127, cq = tid >> 7; const float mean = stats[2 * s], rstd = stats[2 * s + 1];
#pragma unroll
      for (int gi = 0; gi < 2; ++gi) { const int g = 2 * gp + gi;
#pragma unroll
          for (int i = 0; i < 4; ++i) { const int d = 8 * (cq + 4 * i); const bf16x8 v = *(const GAS bf16x8*)(VG + (size_t)(tok0 + s) * SW + g * 128 + d);
              const f32x4 g0 = *(const GAS f32x4*)(gsgu + g * 128 + d), g1 = *(const GAS f32x4*)(gsgu + g * 128 + d + 4);
#pragma unroll
              for (int k = 0; k < 8; ++k) { const float gn = k < 4 ? g0[k & 3] : g1[k & 3]; const float y = (bf2f((unsigned short)v[k]) - mean) * rstd * gn;
                  vnT[(gi * 128 + d + k) * SGU_LDV + s] = (bf16_t)(cvt_pk_bf16(y, 0.f) & 0xffffu); } } } }
    LDS_WAIT(); __syncthreads();
    { const int gi = wid >> 2, tn = wid & 3, g = 2 * gp + gi, r = lane & 31, h = lane >> 5;
      f32x16 acc[4];
#pragma unroll
      for (int mt = 0; mt < 4; ++mt) acc[mt] = f32x16{};
      const GAS bf16_t* wrow = wst + ((size_t)g * 128 + 32 * tn + r) * 128 + 8 * h;
      const int nks = 2 * (tn + 1);
      bf16x8 bfr[8];
#pragma unroll
      for (int ks = 0; ks < 8; ++ks) if (ks < nks) bfr[ks] = *(const GAS bf16x8*)(wrow + 16 * ks);
      const int t = 32 * tn + r; const float bias = bs[g * 128 + t]; const size_t rowoff = (size_t)(tok0 + t) * SW + g * 128;
      u32x2 uu_[4][4];
#pragma unroll
      for (int mt = 0; mt < 4; ++mt)
#pragma unroll
          for (int q = 0; q < 4; ++q) uu_[mt][q] = *(const GAS u32x2*)(U + rowoff + 32 * mt + 8 * q + 4 * h);
#pragma unroll
      for (int ks = 0; ks < 8; ++ks) if (ks < nks) {
#pragma unroll
          for (int mt = 0; mt < 4; ++mt) { const bf16x8 afrag = *(const LAS bf16x8*)(vnT + (gi * 128 + 32 * mt + r) * SGU_LDV + 16 * ks + 8 * h);
              acc[mt] = __builtin_amdgcn_mfma_f32_32x32x16_bf16(afrag, bfr[ks], acc[mt], 0, 0, 0); } }
#pragma unroll
      for (int mt = 0; mt < 4; ++mt)
#pragma unroll
          for (int qp = 0; qp < 2; ++qp) { u32x2 w[2];
#pragma unroll
              for (int k = 0; k < 2; ++k) { const int q = 2 * qp + k; const u32x2 uu = uu_[mt][q];
                  const float o0 = bflo(uu.x) * (acc[mt][4 * q + 0] + bias), o1 = bfhi(uu.x) * (acc[mt][4 * q + 1] + bias), o2 = bflo(uu.y) * (acc[mt][4 * q + 2] + bias), o3 = bfhi(uu.y) * (acc[mt][4 * q + 3] + bias);
                  w[k].x = cvt_pk_bf16(o0, o1); w[k].y = cvt_pk_bf16(o2, o3); }
              const auto sx = __builtin_amdgcn_permlane32_swap(w[0].x, w[1].x, false, false); const auto sy = __builtin_amdgcn_permlane32_swap(w[0].y, w[1].y, false, false);
              u32x4 W; W.x = sx[0]; W.y = sy[0]; W.z = sx[1]; W.w = sy[1];
              *(GAS u32x4*)(OUT + rowoff + 32 * mt + 16 * qp + 8 * h) = W; } }
    __syncthreads();
}

struct Args { const float* in[19]; float* out; unsigned char* ws; int ph_lo, ph_hi; };
constexpr int NPHASE = 19;
#ifndef BG_UPFRONT
#define BG_UPFRONT 1
#endif
constexpr int GW_IN = BG_UPFRONT ? 256 : 231, GW_GU0 = BG_UPFRONT ? 256 : 235;

__device__ __forceinline__ int must_after(int, int) { return CV_TOTAL; }
#define PH_ENTER() int tid = TID0(); asm volatile("" : "+v"(tid)); const int lane = tid & 63, wave = __builtin_amdgcn_readfirstlane(tid >> 6); int bx = bx0; asm volatile("" : "+s"(bx)); \
    GAS unsigned char* ws = (GAS unsigned char*)args.ws; asm volatile("" : "+s"(ws)); const int vcu = (G % 8 == 0) ? (bx % 8) * (G / 8) + bx / 8 : bx; const int gw = vcu * 8 + wave, NGW = G * 8; (void)lane; (void)gw; (void)NGW
template <unsigned PHMASK> __global__ void __launch_bounds__(512, 2) mk_fwd(Args args) {
    extern __shared__ __attribute__((aligned(16))) unsigned char lds_raw[];
    LAS unsigned char* lds = (LAS unsigned char*)lds_raw;
    const int G = gridDim.x, bx0 = blockIdx.x;
    const int wave0 = __builtin_amdgcn_readfirstlane(threadIdx.x >> 6);
#define TID0() (wave0 * 64 + lane_id())
#define ctl ((unsigned*)args.ws)
#define MISC ((volatile LAS unsigned*)(lds + MISC_OFF))
    for (int u = threadIdx.x; u < (LDS_BYTES - RING_BYTES) / 4; u += 512) ((LAS unsigned*)(lds + RING_BYTES))[u] = 0u;
    __syncthreads();
    const int lo = args.ph_lo, hi = args.ph_hi;
    if (hi - lo > 1) (void)xcd_barrier_post((unsigned*)args.ws + CW_BAR, (volatile LAS unsigned*)(lds + MISC_OFF) + 8);
#define GRID_BARRIER() do { if (BAR2) { xcd_barrier2((unsigned*)args.ws + CW_BAR, xb_xcc_id(), (volatile LAS unsigned*)(lds + MISC_OFF) + 8, TID0()); break; } XcdBarrier b_; b_.bar = (unsigned*)args.ws + CW_BAR; b_.x = xb_xcc_id(); b_.st = (volatile LAS unsigned*)(lds + MISC_OFF) + 8; xcd_barrier(b_, TID0() == 0); } while (0)
#define IN(k) (((PHMASK >> (((k) >= 10) ? (k) - 9 : (k))) & 1u) && lo <= (k) && (k) < hi)
#define SEAM(k) do { if (IN(k) && IN((k) + 1)) GRID_BARRIER(); } while (0)
#define RUN(k) (IN(pb + (k)) && (!ex || ((EXMASK >> (k)) & 1u)))
#define SEAM_BG(k, must, LOOKF, NLOOK) do { if (IN(k) && IN((k) + 1)) { if (BG_UPFRONT) { GRID_BARRIER(); break; } PH_ENTER(); if (tid == 0) (void)__hip_atomic_fetch_add(ctl + CW_DONE + 64 * (k), 1u, __ATOMIC_RELAXED, __HIP_MEMORY_SCOPE_AGENT); \
        bg_convert<LOOKF>(args.in, ws, ctl, lds, MISC + 12, lane, wave, bx, G, (must), (k), (NLOOK)); GRID_BARRIER(); } } while (0)
#define SEAMX(k) do { if (!ex) { SEAM_BG(pb + (k), must_after(l, (k)), (!BG_UPFRONT && ((k) == 0 || (k) == 1 || (k) == 6)), ((k) == 1 ? 2 : 7)); } else if (RUN(k)) GRID_BARRIER(); } while (0)

    if (IN(0)) {
        { PH_ENTER();
        bg_convert<false>(args.in, ws, ctl, lds, MISC + 12, lane, wave, bx, G, CV_TOTAL, 0, 0);
        __syncthreads();
        for (;;) {
            if (tid == 0) MISC[16] = __hip_atomic_fetch_add(ctl + CW_Q8Q, 1u, __ATOMIC_RELAXED, __HIP_MEMORY_SCOPE_AGENT);
            LDS_WAIT(); __syncthreads();
            const int sidx = (int)MISC[16];
            __syncthreads();
            if (sidx >= Q8_STRIPS + Q8D_STRIPS) break;
            int tq = tid; asm volatile("" : "+v"(tq));
            if (sidx >= Q8D_STRIPS) q8_strip(args.in, ws, lds, sidx - Q8D_STRIPS, tq); else if (Q8D_REG) q8_strip_down_reg(args.in, ws, lds, sidx, tq); else q8_strip_down(args.in, ws, lds, sidx, tq);
        }
#ifdef P0X_LO
        GRID_BARRIER();
        for (;;) {
            if (tid == 0) MISC[16] = P0X_LO + __hip_atomic_fetch_add(ctl + CW_Q8Q + 64, 1u, __ATOMIC_RELAXED, __HIP_MEMORY_SCOPE_AGENT);
            LDS_WAIT(); __syncthreads();
            const int sidx = (int)MISC[16];
            __syncthreads();
            if (sidx >= P0X_HI) break;
            int tq = tid; asm volatile("" : "+v"(tq));
            if (sidx < Q8_STRIPS) q8_strip(args.in, ws, lds, sidx, tq); else if (Q8D_REG) q8_strip_down_reg(args.in, ws, lds, sidx - Q8_STRIPS, tq); else q8_strip_down(args.in, ws, lds, sidx - Q8_STRIPS, tq);
        }
        GRID_BARRIER();
#endif
        }
        PH_ENTER();
        { const GAS float* wsrc = (const GAS float*)args.in[4]; GAS bf16_t* wdst = (GAS bf16_t*)(ws + WS_WS);
          for (int i = vcu * 512 + tid; i < 2 * 8 * 128 * 128; i += G * 512) { const int s = i & 127, t = (i >> 7) & 127; const float v = s <= t ? wsrc[i] : 0.f; wdst[i] = (bf16_t)(cvt_pk_bf16(v, 0.f) & 0xffffu); } }
        const GAS float* x_in = (const GAS float*)args.in[0];
        { GAS unsigned* H8 = (GAS unsigned*)(ws + WS_H); GAS float* SA = (GAS float*)(ws + WS_SB + 512 * 1024);
          for (int m = gw; m < NTOK; m += NGW) { f32x4 v[8]; rms_row(x_in + (size_t)m * DM, lane, v); store_row_i8((GAS unsigned*)((GAS unsigned char*)H8 + (size_t)m * P8B), SA + m, lane, v); } }
    }
    SEAM_BG(0, CV_END_WIN0, false, 0);

    for (int li = 0; li < (EXMASK ? 3 : 2); ++li) {
        const int l = li < 2 ? li : 1; const bool ex = li >= 2;
        const int pb = 1 + 9 * l;
        if (ex) GRID_BARRIER();
        if (RUN(0)) {
            PH_ENTER();
            pg8::Gemm g{(const bf16_t*)(ws + WS_H), (const bf16_t*)(ws + WS_WIN + (size_t)l * INW * P8B), NTOK, INW, DM / 2, P8B / 2, P8B / 2}; const int Gw = (G == 256) ? GW_IN : G;
            if (bx < Gw) { pg8::StaticOrder S; S.init(NTOK, INW, Gw, bx);
            pg8::EpiIn E{(const GAS float*)(ws + WS_SB + 512 * 1024), (const GAS float*)(ws + WS_SB) + SB_WIN + l * INW, (GAS bf16_t*)(ws + WS_QKVUV), (GAS bf16_t*)(ws + WS_GAB), (GAS float*)(ws + WS_RT + RT_KSUM), (GAS f32x2*)(ws + WS_P1)};
            if (G == 256) { pg8::InOrder SI; SI.c = bx; pg8::gemm_phase<pg8::EpiIn, pg8::InOrder, true, true, true>(lds, g, SI, E, tid); }
            else pg8::gemm_phase<pg8::EpiIn, pg8::StaticOrder, true, true, true>(lds, g, S, E, tid); }
        }
        SEAMX(0);
        if (RUN(1)) {
            PH_ENTER();
            GAS bf16_t* QKVUV = (GAS bf16_t*)(ws + WS_QKVUV);
            const GAS bf16_t* Qb = QKVUV; const GAS bf16_t* Kb = QKVUV + (size_t)NTOK * 1024; const GAS bf16_t* Vb = QKVUV + (size_t)2 * NTOK * 1024;
            const GAS bf16_t* Ub = QKVUV + (size_t)3 * NTOK * 1024; const GAS bf16_t* VGb = QKVUV + (size_t)4 * NTOK * 1024;
#if ATT_KV2
            for (int a = bx; a < 256; a += G) { const int i = a >> 3; const int bh = (a & 7) * 4 + (i >> 3), j = i & 7;
#pragma unroll 1
                for (int uu = 0; uu < 2; ++uu) { const int idx = uu ? 15 - j : j; int ta = tid; asm volatile("" : "+v"(ta));
                    att::attn_unit3(bh >> 3, bh & 7, idx >> 1, idx & 1, Qb, Kb, Vb, (GAS bf16_t*)(ws + WS_ATT), (const GAS float*)(ws + WS_RT + RT_KSUM), (char*)lds_raw, ta); } }
#else
            for (int a = bx; a < 256; a += G) { const int i = a >> 3; const int bh = (a & 7) * 4 + (i >> 3), qb = i & 7;
                att::attn_unit(bh >> 3, bh & 7, qb, Qb, Kb, Vb, (GAS bf16_t*)(ws + WS_ATT), (const GAS float*)(ws + WS_RT + RT_KSUM), (char*)lds_raw, tid); }
#endif
            __syncthreads();
            const GAS float* gsgu = (const GAS float*)args.in[3] + l * SW; const GAS bf16_t* wst = (const GAS bf16_t*)(ws + WS_WS) + (size_t)l * 8 * 128 * 128; const GAS float* bs = (const GAS float*)args.in[5] + l * 8 * 128;
            GAS bf16_t* SGUO = (GAS bf16_t*)(ws + WS_SGU);
#if ATT_KV2
            if (G == 256) { const int sidx = (bx & 7) * 32 + (bx >> 3); int ts = tid; asm volatile("" : "+v"(ts));
                sgu_unit(sidx >> 6, (sidx >> 2) & 15, sidx & 3, Ub, VGb, SGUO, gsgu, wst, bs, (const GAS f32x2*)(ws + WS_P1), lds, ts); }
            else
#endif
            if (G == 256) { const int i = bx >> 3, qb = i & 7;
                if (qb < 4) { const int lr = (bx & 7) + 8 * ((i >> 3) * 4 + qb);
                    for (int s = lr; s < 256; s += 128) sgu_unit(s >> 6, (s >> 2) & 15, s & 3, Ub, VGb, SGUO, gsgu, wst, bs, (const GAS f32x2*)(ws + WS_P1), lds, tid); } }
            else { for (int s = bx; s < 256; s += G) sgu_unit(s >> 6, (s >> 2) & 15, s & 3, Ub, VGb, SGUO, gsgu, wst, bs, (const GAS f32x2*)(ws + WS_P1), lds, tid); }
        }
        SEAMX(1);
        if (RUN(2)) {
            PH_ENTER();
            pg8::Gemm g{(const bf16_t*)(ws + WS_ATT), (const bf16_t*)(ws + WS_WPA) + (size_t)l * 2 * DM * AW, 2 * NTOK, 2 * DM, AW};
            pg8::PairOrder S; S.init(NTOK, DM, G, bx); S.a_off = NTOK / 256; S.b_off = DM / 256;
            pg8::EpiMrg E{(const GAS unsigned char*)(ws + WS_GAB), (const GAS unsigned char*)(ws + WS_GAB) + (size_t)NTOK * 2048, (GAS bf16_t*)(ws + WS_MRG)};
            pg8::gemm_phase<pg8::EpiMrg, pg8::PairOrder, true, true>(lds, g, S, E, tid);
        }
        SEAMX(2);
        if (RUN(3)) {
            PH_ENTER();
            pg8::Gemm g{(const bf16_t*)(ws + WS_MRG), (const bf16_t*)(ws + WS_WO) + (size_t)l * DM * DM, NTOK, DM, DM}; pg8::StaticOrder S; S.init(NTOK, DM, G, bx);
            if (l == 0) { pg8::EpiRes<true> E{(const GAS float*)args.in[0], nullptr, (GAS bf16_t*)(ws + WS_X)}; pg8::gemm_phase<pg8::EpiRes<true>, pg8::StaticOrder, true, true>(lds, g, S, E, tid); }
            else { pg8::EpiRes<false> E{nullptr, (const GAS bf16_t*)(ws + WS_X), (GAS bf16_t*)(ws + WS_X)}; pg8::gemm_phase<pg8::EpiRes<false>, pg8::StaticOrder, true, true>(lds, g, S, E, tid); }
        }
        SEAMX(3);
        if (RUN(4)) {
            PH_ENTER();
            const GAS bf16_t* X = (const GAS bf16_t*)(ws + WS_X);
            if (l == 0) { GAS unsigned* H8 = (GAS unsigned*)(ws + WS_H); GAS float* SA = (GAS float*)(ws + WS_SB + 512 * 1024);
                for (int m = gw; m < NTOK; m += NGW) { f32x4 v[8]; rms_row_bf(X + (size_t)m * DM, lane, v); store_row_i8((GAS unsigned*)((GAS unsigned char*)H8 + (size_t)m * P8B), SA + m, lane, v); } }
            else { const GAS float* gain = (const GAS float*)args.in[9] + DM; const GAS float* wr = (const GAS float*)args.in[13]; const GAS float* br = (const GAS float*)args.in[14];
                GAS int* TE = (GAS int*)(ws + WS_RT + RT_TE); GAS int* TP = (GAS int*)(ws + WS_RT + RT_TP); GAS float* TW = (GAS float*)(ws + WS_RT + RT_TW);
                if (G == 256) {
                    GAS bf16_t* XG = (GAS bf16_t*)(ws + WS_XG); GAS int* TS = (GAS int*)(ws + WS_RT + RT_TS); GAS float* CWT = (GAS float*)(ws + WS_RT + RT_CW);
                    LAS float* wrt = (LAS float*)lds;
                    for (int k = tid; k < DM; k += 512) { const f32x4 a = *(const GAS f32x4*)(wr + (size_t)k * 8), b = *(const GAS f32x4*)(wr + (size_t)k * 8 + 4);
                        wrt[0 * DM + k] = a.x; wrt[1 * DM + k] = a.y; wrt[2 * DM + k] = a.z; wrt[3 * DM + k] = a.w; wrt[4 * DM + k] = b.x; wrt[5 * DM + k] = b.y; wrt[6 * DM + k] = b.z; wrt[7 * DM + k] = b.w; }
                    LDS_WAIT(); __syncthreads();
                    unsigned hr[4][8]; float rsa[4]; int re0[4], re1[4], rp0[4], rp1[4]; float rw0[4], rw1[4];
                    GAS float* SAG = (GAS float*)(ws + WS_SB + 640 * 1024);
#pragma unroll
                    for (int i = 0; i < 4; ++i) { const int m = gw + i * NGW; f32x4 v[8]; rms_row_bf(X + (size_t)m * DM, lane, v);
                        { float am = 0.f;
#pragma unroll
                          for (int j = 0; j < 8; ++j) am = fmaxf(am, fmaxf(fmaxf(fabsf(v[j].x), fabsf(v[j].y)), fmaxf(fabsf(v[j].z), fabsf(v[j].w))));
                          am = wave_max(am); const float inv = am > 0.f ? 127.0f / am : 0.f; float rs_ = am > 0.f ? am * (1.0f / 127.0f) : 1.0f; asm volatile("" : "+v"(rs_)); rsa[i] = rs_;
#pragma unroll
                          for (int j = 0; j < 8; ++j) { unsigned pk_ = pack_i8x4(v[j], inv); asm volatile("" : "+v"(pk_)); hr[i][j] = pk_; } }
                        const GAS f32x4* gr = (const GAS f32x4*)gain + lane;
                        float lg[8];
#pragma unroll
                        for (int e = 0; e < 8; ++e) lg[e] = 0.f;
#pragma unroll
                        for (int j = 0; j < 8; ++j) { const f32x4 hg = v[j] * gr[64 * j];
#pragma unroll
                            for (int e = 0; e < 8; ++e) { const f32x4 w4 = *(const LAS f32x4*)(wrt + e * DM + 4 * lane + 256 * j); lg[e] += (hg.x * w4.x + hg.y * w4.y) + (hg.z * w4.z + hg.w * w4.w); } }
#pragma unroll
                        for (int e = 0; e < 8; ++e) lg[e] = wave_sum(lg[e]) + br[e];
                        int e0 = 0; float v0 = lg[0];
#pragma unroll
                        for (int e = 1; e < 8; ++e) if (lg[e] > v0) { v0 = lg[e]; e0 = e; }
                        int e1 = e0 == 0 ? 1 : 0; float v1 = -__builtin_inff();
#pragma unroll
                        for (int e = 0; e < 8; ++e) if (e != e0 && lg[e] > v1) { v1 = lg[e]; e1 = e; }
                        const float ex = __expf(v1 - v0);
                        unsigned p0 = 0u, p1 = 0u; if (lane == 0) { p0 = atomicAdd(ctl + CW_CNT + 64 * e0, 1u); p1 = atomicAdd(ctl + CW_CNT + 64 * e1, 1u); }
                        re0[i] = e0; re1[i] = e1; rp0[i] = (int)__builtin_amdgcn_readfirstlane(p0); rp1[i] = (int)__builtin_amdgcn_readfirstlane(p1); { float a_ = 1.0f / (1.0f + ex), b_ = ex / (1.0f + ex); asm volatile("" : "+v"(a_), "+v"(b_)); rw0[i] = a_; rw1[i] = b_; }
                        asm volatile("" ::: "memory"); }
                    asm volatile("s_waitcnt vmcnt(0)" ::: "memory"); __syncthreads();
                    if (tid == 0) { (void)__hip_atomic_fetch_add(ctl + CW_ROUTED, 1u, __ATOMIC_RELAXED, __HIP_MEMORY_SCOPE_AGENT); unsigned sp = 0;
                        while (__hip_atomic_load(ctl + CW_ROUTED, __ATOMIC_RELAXED, __HIP_MEMORY_SCOPE_AGENT) < (unsigned)G) { __builtin_amdgcn_s_sleep(1); if (++sp > (1u << 22)) break; } }
                    __syncthreads();
                    int rb[8]; { int acc = 0;
#pragma unroll
                        for (int e = 0; e < 8; ++e) { rb[e] = acc; acc += (int)(((__builtin_amdgcn_readfirstlane(__hip_atomic_load(ctl + CW_CNT + 64 * e, __ATOMIC_RELAXED, __HIP_MEMORY_SCOPE_AGENT)) + 255u) >> 8) << 8); } }
#pragma unroll
                    for (int i = 0; i < 4; ++i) { const int m = gw + i * NGW; int b0 = 0, b1 = 0;
#pragma unroll
                        for (int e = 0; e < 8; ++e) { b0 = (e == re0[i]) ? rb[e] : b0; b1 = (e == re1[i]) ? rb[e] : b1; }
                        const int s0 = b0 + rp0[i], s1 = b1 + rp1[i];
                        GAS unsigned* d0 = (GAS unsigned*)((GAS unsigned char*)XG + (size_t)s0 * P8B) + lane; GAS unsigned* d1 = (GAS unsigned*)((GAS unsigned char*)XG + (size_t)s1 * P8B) + lane;
#pragma unroll
                        for (int j = 0; j < 8; ++j) { d0[64 * j] = hr[i][j]; d1[64 * j] = hr[i][j]; }
                        if (lane == 0) { TS[2 * m] = s0; TS[2 * m + 1] = s1; CWT[s0] = rw0[i]; CWT[s1] = rw1[i]; SAG[s0] = rsa[i]; SAG[s1] = rsa[i]; } }
                } }
        }
        SEAMX(4);
        if (RUN(6)) {
            PH_ENTER();
            const int Gw = (G == 256 && l == 0) ? GW_GU0 : G;
            if (bx < Gw) {
            pg8::GroupOrder S; S.init(l == 0 ? nullptr : (const unsigned*)(ctl + CW_CNT), 44, Gw, bx);
            if (G == 256) {
            pg8::Gemm g{l == 0 ? (const bf16_t*)(ws + WS_H) : (const bf16_t*)(ws + WS_XG), l == 0 ? (const bf16_t*)(ws + WS_WGU) : (const bf16_t*)(ws + WS_WEGU), 0, 0, DM / 2, P8B / 2, P8B / 2};
            pg8::EpiGU8 E{(GAS bf16_t*)(ws + WS_ACT), 44, (const GAS float*)(ws + WS_SB + (l == 0 ? 512 : 640) * 1024), (const GAS float*)(ws + WS_SB) + (l == 0 ? 0 : 11264)};
            pg8::gemm_phase<pg8::EpiGU8, pg8::GroupOrder, true, true, true>(lds, g, S, E, tid);
            } }
        }
        SEAMX(6);
        if (RUN(7)) {
            PH_ENTER();
            int nrows = 0;
#pragma unroll
            for (int e = 0; e < 8; ++e) nrows += (int)(((__builtin_amdgcn_readfirstlane(__hip_atomic_load(ctl + CW_CNT + 64 * e, __ATOMIC_RELAXED, __HIP_MEMORY_SCOPE_AGENT)) + 255u) >> 8) << 8);
            if (l == 0) nrows = NTOK;
            GAS float* SACT = (GAS float*)(ws + WS_SB + 768 * 1024); const GAS float* CWT = (const GAS float*)(ws + WS_RT + RT_CW);
            for (int r = gw; r < nrows; r += NGW) { GAS unsigned char* rowp = ws + WS_ACT + (size_t)r * (FF * 2); u32x4 v[11];
#pragma unroll
                for (int j = 0; j < 11; ++j) v[j] = *(const GAS u32x4*)(rowp + lane * 16 + j * 1024);
                float am = 0.f;
#pragma unroll
                for (int j = 0; j < 11; ++j) am = fmaxf(am, fmaxf(fmaxf(fmaxf(fabsf(bflo(v[j].x)), fabsf(bfhi(v[j].x))), fmaxf(fabsf(bflo(v[j].y)), fabsf(bfhi(v[j].y)))), fmaxf(fmaxf(fabsf(bflo(v[j].z)), fabsf(bfhi(v[j].z))), fmaxf(fabsf(bflo(v[j].w)), fabsf(bfhi(v[j].w))))));
                am = wave_max(am); const float inv = am > 0.f ? 127.0f / am : 0.f;
#pragma unroll
                for (int j = 0; j < 11; ++j) { u32x2 o; o.x = pack_i8x4((f32x4){bflo(v[j].x), bfhi(v[j].x), bflo(v[j].y), bfhi(v[j].y)}, inv); o.y = pack_i8x4((f32x4){bflo(v[j].z), bfhi(v[j].z), bflo(v[j].w), bfhi(v[j].w)}, inv);
                    *(GAS u32x2*)(rowp + lane * 8 + j * 512) = o; }
                if (lane == 0) SACT[r] = (am > 0.f ? am * (1.0f / 127.0f) : 1.0f) * (l == 1 ? CWT[r] : 1.0f); }
            GRID_BARRIER();
        }
        if (RUN(7)) {
            PH_ENTER();
            if (l == 0) {
            pg8::DownOrderT<44> S; S.init(nullptr, G, bx);
            pg8::Gemm g{(const bf16_t*)(ws + WS_ACT), (const bf16_t*)(ws + WS_WD), 0, 0, FF / 2, FF, FF};
            pg8::EpiResX8 E{(const GAS float*)(ws + WS_SB + 768 * 1024), (const GAS float*)(ws + WS_SB) + SB_WD, (GAS bf16_t*)(ws + WS_X)};
            pg8::gemm_phase<pg8::EpiResX8, pg8::DownOrderT<44>, true, true, true>(lds, g, S, E, tid);
            } else {
            pg8::DownOrderT<44> S; S.init((const unsigned*)(ctl + CW_CNT), G, bx);
            pg8::Gemm g{(const bf16_t*)(ws + WS_ACT), (const bf16_t*)(ws + WS_WED), 0, 0, FF / 2, FF, FF};
            pg8::EpiRes8 E{(const GAS float*)(ws + WS_SB + 768 * 1024), (const GAS float*)(ws + WS_SB) + SB_WED, (GAS bf16_t*)(ws + WS_YP), S.psplit0 * 256, (GAS bf16_t*)(ws + WS_Y)};
            pg8::gemm_phase<pg8::EpiRes8, pg8::DownOrderT<44>, true, true, true>(lds, g, S, E, tid);
            }
        }
        SEAMX(7);
        if (RUN(8)) {
            PH_ENTER();
            const GAS bf16_t* X = (const GAS bf16_t*)(ws + WS_X);
            if (l == 0) { GAS unsigned* H8 = (GAS unsigned*)(ws + WS_H); GAS float* SA = (GAS float*)(ws + WS_SB + 512 * 1024); for (int m = gw; m < NTOK; m += NGW) { f32x4 v[8]; rms_row_bf(X + (size_t)m * DM, lane, v); store_row_i8((GAS unsigned*)((GAS unsigned char*)H8 + (size_t)m * P8B), SA + m, lane, v); } }
            else { const GAS float* gain = (const GAS float*)args.in[18]; const GAS bf16_t* Y = (const GAS bf16_t*)(ws + WS_Y); const GAS int* TS = (const GAS int*)(ws + WS_RT + RT_TS);
                const GAS bf16_t* YP = (const GAS bf16_t*)(ws + WS_YP);
                int split_row0; { int P = 0;
#pragma unroll
                    for (int e = 0; e < 8; ++e) P += (int)((__builtin_amdgcn_readfirstlane(__hip_atomic_load(ctl + CW_CNT + 64 * e, __ATOMIC_RELAXED, __HIP_MEMORY_SCOPE_AGENT)) + 255u) >> 8);
                    split_row0 = (P - pg8::moe_split_r(P, G)) * 256; }
                for (int m = gw; m < NTOK; m += NGW) { const int s0 = TS[2 * m], s1 = TS[2 * m + 1];
                    const GAS u32x2* xr = (const GAS u32x2*)(X + (size_t)m * DM) + lane; const GAS u32x2* y0 = (const GAS u32x2*)(Y + (size_t)s0 * DM) + lane; const GAS u32x2* y1 = (const GAS u32x2*)(Y + (size_t)s1 * DM) + lane;
                    f32x4 v[8]; float s = 0.f;
#pragma unroll
                    for (int j = 0; j < 8; ++j) { const u32x2 a = y0[64 * j], b = y1[64 * j], xw = xr[64 * j]; v[j] = (f32x4){bflo(xw.x), bfhi(xw.x), bflo(xw.y), bfhi(xw.y)} + (f32x4){bflo(a.x), bfhi(a.x), bflo(a.y), bfhi(a.y)} + (f32x4){bflo(b.x), bfhi(b.x), bflo(b.y), bfhi(b.y)}; }
                    if (s0 >= split_row0) { const GAS u32x2* p = (const GAS u32x2*)(YP + (size_t)(s0 - split_row0) * DM) + lane;
#pragma unroll
                        for (int j = 0; j < 8; ++j) { const u32x2 a = p[64 * j], b = p[64 * j + (size_t)2048 * DM / 4], c = p[64 * j + (size_t)2 * 2048 * DM / 4];
                            v[j] += ((f32x4){bflo(a.x), bfhi(a.x), bflo(a.y), bfhi(a.y)} + (f32x4){bflo(b.x), bfhi(b.x), bflo(b.y), bfhi(b.y)}) + (f32x4){bflo(c.x), bfhi(c.x), bflo(c.y), bfhi(c.y)}; } }
                    if (s1 >= split_row0) { const GAS u32x2* p = (const GAS u32x2*)(YP + (size_t)(s1 - split_row0) * DM) + lane;
#pragma unroll
                        for (int j = 0; j < 8; ++j) { const u32x2 a = p[64 * j], b = p[64 * j + (size_t)2048 * DM / 4], c = p[64 * j + (size_t)2 * 2048 * DM / 4];
                            v[j] += ((f32x4){bflo(a.x), bfhi(a.x), bflo(a.y), bfhi(a.y)} + (f32x4){bflo(b.x), bfhi(b.x), bflo(b.y), bfhi(b.y)}) + (f32x4){bflo(c.x), bfhi(c.x), bflo(c.y), bfhi(c.y)}; } }
#pragma unroll
                    for (int j = 0; j < 8; ++j) s += (v[j].x * v[j].x + v[j].y * v[j].y) + (v[j].z * v[j].z + v[j].w * v[j].w);
                    const float rstd = 1.0f / sqrtf(wave_sum(s) * (1.0f / DM) + EPS);
                    const GAS f32x4* gr = (const GAS f32x4*)gain + lane; GAS f32x4* orow = (GAS f32x4*)((GAS float*)args.out + (size_t)m * DM) + lane;
#pragma unroll
                    for (int j = 0; j < 8; ++j) orow[64 * j] = v[j] * rstd * gr[64 * j]; } }
        }
        if (l == 0 || EXMASK) SEAMX(8);
    }
#undef IN
#undef SEAM
}

template <unsigned MASK> static bool setup_one() {
    if (hipFuncSetAttribute((const void*)mk_fwd<MASK>, hipFuncAttributeMaxDynamicSharedMemorySize, LDS_BYTES) != hipSuccess) { fprintf(stderr, "kernel_launch: hipFuncSetAttribute failed (mask %x)\n", MASK); return false; }
    return true;
}
template <unsigned MASK> static void launch_one(int grid, hipStream_t stream, const Args& a) { hipLaunchKernelGGL(mk_fwd<MASK>, dim3(grid), dim3(512), LDS_BYTES, stream, a); }
extern "C" void kernel_launch(void* const* d_in, const int* in_sizes, int n_in, void* d_out, int out_size, void* d_ws, size_t ws_size, hipStream_t stream) {
    static int grid = 0;
    if (grid == 0) {
        if (n_in != 19 || out_size != NTOK * DM || ws_size < WS_END) { fprintf(stderr, "kernel_launch: unexpected shapes (n_in %d out %d ws %zu need %zu)\n", n_in, out_size, ws_size, (size_t)WS_END); grid = -1; return; }
        int dev = 0, cus = 0;
        if (hipGetDevice(&dev) != hipSuccess || hipDeviceGetAttribute(&cus, hipDeviceAttributeMultiprocessorCount, dev) != hipSuccess) { grid = -1; return; }
#if MK_ONE_LAUNCH
        bool ok = setup_one<0xFFFFFFFFu>();
        int per_cu = 0; if (hipOccupancyMaxActiveBlocksPerMultiprocessor(&per_cu, (const void*)mk_fwd<0xFFFFFFFFu>, 512, LDS_BYTES) != hipSuccess || per_cu < 1) fprintf(stderr, "kernel_launch: occupancy query says %d\n", per_cu);
#else
        bool ok = setup_one<1u>() && setup_one<2u>() && setup_one<4u>() && setup_one<8u>() && setup_one<16u>() && setup_one<32u>() && setup_one<64u>() && setup_one<128u>() && setup_one<256u>() && setup_one<512u>();
#endif
        (void)hipGetLastError();
        if (!ok) { grid = -1; return; }
        if (cus != 256) { fprintf(stderr, "kernel_launch: this build is laid out for 256 CUs (found %d); nothing launched\n", cus); grid = -1; return; }
        grid = cus;
    }
    if (grid < 0) return;
    (void)hipMemsetAsync((char*)d_ws + WS_CTL, 0, 1 * MiB, stream);
    Args a{};
    for (int i = 0; i < 19; ++i) a.in[i] = (const float*)d_in[i];
    a.out = (float*)d_out; a.ws = (unsigned char*)d_ws;
#if MK_ONE_LAUNCH
    a.ph_lo = 0; a.ph_hi = NPHASE;
    launch_one<0xFFFFFFFFu>(grid, stream, a);
#else
    for (int p = 0; p < NPHASE; ++p) { if (p == 6) continue;
        a.ph_lo = p; a.ph_hi = p + 1;
        const int bit = p >= 10 ? p - 9 : p;
        switch (bit) {
            case 0: launch_one<1u>(grid, stream, a); break; case 1: launch_one<2u>(grid, stream, a); break; case 2: launch_one<4u>(grid, stream, a); break;
            case 3: launch_one<8u>(grid, stream, a); break; case 4: launch_one<16u>(grid, stream, a); break; case 5: launch_one<32u>(grid, stream, a); break;
            case 6: launch_one<64u>(grid, stream, a); break; case 7: launch_one<128u>(grid, stream, a); break; case 8: launch_one<256u>(grid, stream, a); break;
            default: launch_one<512u>(grid, stream, a); break; } }
#endif
}
```
